# Optimizing an MI355X kernel written in HIP

```python
import math
import jax
import jax.numpy as jnp
from jax import lax
import numpy as np


D_MODEL = 1024
BATCH = 8
SEQ = 4096
DEPTH = 1

HEAD_DIM = 64
N_HEADS_SB = 8
N_HEADS_MB = 8
D_SB = N_HEADS_SB * HEAD_DIM
D_MB = N_HEADS_MB * HEAD_DIM
D_MIX = D_SB + D_MB
D_PLE = 256
SB_QBLOCK = 128
MOBA_BLOCK = 256
MOBA_TOPK = 3
MOBA_QCHUNK = 16
RMS_EPS = 1e-6

kernel_name = "hybrid_stickbreak_moba_layer"


def rmsnorm(x, g):
    xf = x.astype(jnp.float32)
    y = xf * lax.rsqrt(jnp.mean(xf * xf, axis=-1, keepdims=True) + RMS_EPS)
    return (y * g.astype(jnp.float32)).astype(x.dtype)


def split_heads(t, n_heads):
    b, s, _ = t.shape
    return t.reshape(b, s, n_heads, HEAD_DIM).transpose(0, 2, 1, 3)


def merge_heads(t):
    b, h, s, d = t.shape
    return t.transpose(0, 2, 1, 3).reshape(b, s, h * d)


def alibi_slopes(n_heads):
    return jnp.asarray(np.power(2.0, -8.0 * np.arange(1, n_heads + 1) / n_heads).astype(np.float32))


def stick_breaking_attention(q, k, v):
    b, h, s, d = q.shape
    scale = 1.0 / math.sqrt(d)
    qf = q.astype(jnp.float32)
    kf = k.astype(jnp.float32)
    vf = v.astype(jnp.float32)
    outs = []
    for i in range(s // SB_QBLOCK):
        t0 = i * SB_QBLOCK
        t1 = t0 + SB_QBLOCK
        z = jnp.einsum("bhqd,bhkd->bhqk", qf[:, :, t0:t1], kf[:, :, :t1]) * scale
        past = jnp.arange(t1)[None, :] < (t0 + jnp.arange(SB_QBLOCK))[:, None]
        log_keep = jnp.where(past, jax.nn.log_sigmoid(-z), 0.0)
        log_after = lax.cumsum(log_keep, axis=3, reverse=True) - log_keep
        w = jnp.where(past, jnp.exp(jax.nn.log_sigmoid(z) + log_after), 0.0)
        outs.append(jnp.einsum("bhqk,bhkd->bhqd", w, vf[:, :, :t1]))
    return jnp.concatenate(outs, axis=2).astype(v.dtype)


def moba_attention(q, k, v, slopes):
    b, h, s, d = q.shape
    scale = 1.0 / math.sqrt(d)
    n_blk = -(-s // MOBA_BLOCK)
    s_pad = n_blk * MOBA_BLOCK
    pad = ((0, 0), (0, 0), (0, s_pad - s), (0, 0))
    qf = jnp.pad(q.astype(jnp.float32), pad)
    kf = jnp.pad(k.astype(jnp.float32), pad)
    vf = jnp.pad(v.astype(jnp.float32), pad)
    kb = kf.reshape(b, h, n_blk, MOBA_BLOCK, d)
    vb = vf.reshape(b, h, n_blk, MOBA_BLOCK, d)

    k_mean = kb.mean(axis=3)
    gate = jnp.einsum("bhsd,bhnd->bhsn", qf, k_mean)
    q_blk = jnp.arange(s_pad) // MOBA_BLOCK
    fully_past = jnp.arange(n_blk)[None, :] < q_blk[:, None]
    gate = jnp.where(fully_past, gate, -jnp.inf)
    k_sel = min(MOBA_TOPK, n_blk)
    _, sel = lax.top_k(gate, k_sel)

    n_chunk = s_pad // MOBA_QCHUNK
    q_c = qf.reshape(b, h, n_chunk, MOBA_QCHUNK, d).transpose(2, 0, 1, 3, 4)
    sel_c = sel.reshape(b, h, n_chunk, MOBA_QCHUNK, k_sel).transpose(2, 0, 1, 3, 4)
    starts = jnp.arange(n_chunk, dtype=jnp.int32) * MOBA_QCHUNK
    b_ix = jnp.arange(b)[:, None, None, None]
    h_ix = jnp.arange(h)[None, :, None, None]
    offs = jnp.arange(MOBA_BLOCK)
    n_g = k_sel * MOBA_BLOCK

    def chunk(args):
        qc, sc, t0 = args
        q_pos = t0 + jnp.arange(MOBA_QCHUNK)
        blk = t0 // MOBA_BLOCK
        k_g = kb[b_ix, h_ix, sc]
        v_g = vb[b_ix, h_ix, sc]
        k_pos = sc[..., None] * MOBA_BLOCK + offs
        s_g = jnp.einsum("bhqd,bhqnkd->bhqnk", qc, k_g) * scale
        s_g = s_g - slopes[:, None, None, None] * (q_pos[:, None, None] - k_pos).astype(jnp.float32)
        s_g = jnp.where((jnp.arange(k_sel) < blk)[:, None], s_g, -jnp.inf)
        k_own = lax.dynamic_index_in_dim(kb, blk, axis=2, keepdims=False)
        v_own = lax.dynamic_index_in_dim(vb, blk, axis=2, keepdims=False)
        own_pos = blk * MOBA_BLOCK + offs
        s_o = jnp.einsum("bhqd,bhkd->bhqk", qc, k_own) * scale
        s_o = s_o - slopes[:, None, None] * (q_pos[:, None] - own_pos[None, :]).astype(jnp.float32)
        s_o = jnp.where(own_pos[None, :] <= q_pos[:, None], s_o, -jnp.inf)
        probs = jax.nn.softmax(
            jnp.concatenate([s_g.reshape(b, h, MOBA_QCHUNK, n_g), s_o], axis=-1), axis=-1)
        out = jnp.einsum("bhqn,bhqnd->bhqd", probs[..., :n_g],
                         v_g.reshape(b, h, MOBA_QCHUNK, n_g, d))
        out = out + jnp.einsum("bhqk,bhkd->bhqd", probs[..., n_g:], v_own)
        return out

    out = lax.map(chunk, (q_c, sel_c, starts))
    out = out.transpose(1, 2, 0, 3, 4).reshape(b, h, s_pad, d)[:, :, :s]
    return out.astype(v.dtype)


def setup_inputs(seed: int = 0) -> dict:
    key = jax.random.key(seed)
    ks = jax.random.split(key, 11)
    f32 = jnp.float32
    x = jax.random.normal(ks[0], (BATCH, SEQ, D_MODEL), f32)
    p = jax.random.normal(ks[1], (DEPTH, BATCH, SEQ, D_PLE), f32)
    w_in = jax.random.normal(ks[2], (DEPTH, D_MODEL, 4 * D_MIX), f32) * D_MODEL ** -0.5
    g_mix = 1.0 + 0.02 * jax.random.normal(ks[3], (DEPTH, D_MODEL), f32)
    g_out_sb = 1.0 + 0.02 * jax.random.normal(ks[4], (DEPTH, D_SB), f32)
    g_out_mb = 1.0 + 0.02 * jax.random.normal(ks[5], (DEPTH, D_MB), f32)
    w_out = jax.random.normal(ks[6], (DEPTH, D_MIX, D_MODEL), f32) * D_MIX ** -0.5
    w_ple = jax.random.normal(ks[7], (DEPTH, D_PLE, D_MODEL), f32) * D_PLE ** -0.5
    g_ple = 1.0 + 0.02 * jax.random.normal(ks[8], (DEPTH, D_MODEL), f32)
    w_ple_gate = jax.random.normal(ks[9], (DEPTH, D_MODEL, D_MODEL), f32) * D_MODEL ** -0.5
    g_final = 1.0 + 0.02 * jax.random.normal(ks[10], (D_MODEL,), f32)
    return {"x": x, "p": p, "w_in": w_in, "g_mix": g_mix, "g_out_sb": g_out_sb,
            "g_out_mb": g_out_mb, "w_out": w_out, "w_ple": w_ple, "g_ple": g_ple,
            "w_ple_gate": w_ple_gate, "g_final": g_final}


def reference(x, p, w_in, g_mix, g_out_sb, g_out_mb, w_out, w_ple, g_ple, w_ple_gate, g_final):
    slopes = alibi_slopes(N_HEADS_MB)
    widths = [D_SB] * 4 + [D_MB] * 4
    split_at = [int(o) for o in np.cumsum(widths)[:-1]]
    for i in range(DEPTH):
        h = rmsnorm(x, g_mix[i])
        proj = h @ w_in[i]
        q_sb, k_sb, v_sb, z_sb, q_mb, k_mb, v_mb, z_mb = jnp.split(proj, split_at, axis=-1)
        o_sb = merge_heads(stick_breaking_attention(
            split_heads(q_sb, N_HEADS_SB), split_heads(k_sb, N_HEADS_SB),
            split_heads(v_sb, N_HEADS_SB)))
        o_mb = merge_heads(moba_attention(
            split_heads(q_mb, N_HEADS_MB), split_heads(k_mb, N_HEADS_MB),
            split_heads(v_mb, N_HEADS_MB), slopes))
        y_sb = rmsnorm(o_sb, g_out_sb[i]) * jax.nn.silu(z_sb)
        y_mb = rmsnorm(o_mb, g_out_mb[i]) * jax.nn.silu(z_mb)
        x = x + jnp.concatenate([y_sb, y_mb], axis=-1) @ w_out[i]
        ple_gate = jax.nn.sigmoid(rmsnorm(x, g_ple[i]) @ w_ple_gate[i])
        x = x + (p[i] @ w_ple[i]) * ple_gate
    return rmsnorm(x, g_final)
```

```cpp
#include <hip/hip_runtime.h>
#include <cstdio>
#include <cstdint>

typedef unsigned short bf16_t;
constexpr int NB = 8, SEQ = 4096, MTOK = NB * SEQ, DM = 1024, NPROJ = 4096, DPLE = 256, NH = 8, HD = 64;
constexpr float RMS_EPS = 1e-6f;
constexpr float LOG2E = 1.4426950408889634f;
constexpr float C2 = 0.125f * LOG2E;

constexpr size_t MiB = 1u << 20;
constexpr size_t WS_CTL = 0;
constexpr size_t WS_WT_IN = 2 * MiB;
constexpr size_t WS_WT_OUT = 10 * MiB;
constexpr size_t WS_WT_GATE = 12 * MiB;
constexpr size_t WS_WT_PLE = 14 * MiB;
constexpr size_t WS_KSUM = 15 * MiB;
constexpr size_t WS_SSQ = 16 * MiB;
constexpr size_t WS_SSQ1 = 18 * MiB;
constexpr size_t WS_XN = 32 * MiB;
constexpr size_t WS_Y = 32 * MiB;
constexpr size_t WS_PB = 96 * MiB;
constexpr size_t WS_PLE = 112 * MiB;
constexpr size_t WS_X1 = 176 * MiB;
constexpr size_t WS_PROJ = 240 * MiB;
constexpr size_t WS_END = 496 * MiB;

__device__ __forceinline__ float bf2f(bf16_t v) { return __uint_as_float((unsigned)v << 16); }
__device__ __forceinline__ bf16_t f2bf(float f) { unsigned u = __float_as_uint(f); return (bf16_t)((u + 0x7fffu + ((u >> 16) & 1u)) >> 16); }

__global__ void nv_transpose_w(const float* W, int K, int N, bf16_t* WT, const float* rs) {
    size_t i = (size_t)blockIdx.x * blockDim.x + threadIdx.x;
    if (i >= (size_t)K * N) return;
    int n = (int)(i / K), k = (int)(i % K);
    float v = W[(size_t)k * N + n];
    if (rs) v *= rs[k];
    WT[i] = f2bf(v);
}
__global__ void nv_rmsnorm_bf16(const float* x, const float* g, bf16_t* xn) {
    int row = blockIdx.x * 4 + (threadIdx.x >> 6), lane = threadIdx.x & 63;
    const float* xr = x + (size_t)row * DM;
    float v[16]; float s = 0.f;
#pragma unroll
    for (int j = 0; j < 16; ++j) { v[j] = xr[lane + 64 * j]; s += v[j] * v[j]; }
#pragma unroll
    for (int o = 1; o < 64; o <<= 1) s += __shfl_xor(s, o);
    float rstd = rsqrtf(s * (1.f / DM) + RMS_EPS);
#pragma unroll
    for (int j = 0; j < 16; ++j) xn[(size_t)row * DM + lane + 64 * j] = f2bf(v[j] * rstd * g[lane + 64 * j]);
}
__global__ void nv_cvt_bf16(const float* p, bf16_t* o, size_t n) {
    size_t i = (size_t)blockIdx.x * blockDim.x + threadIdx.x;
    if (i < n) o[i] = f2bf(p[i]);
}

struct EpiP {
    bf16_t* obf; float* of32; const float* x; const float* ssq; const float* ssq1; const bf16_t* x1; const bf16_t* ple; int pad0, pad1;
};
enum { EPI_PROJ = 0, EPI_PLE = 1, EPI_OUT = 2, EPI_GATE = 3 };

template <int MODE>
__global__ __launch_bounds__(256) void nv_gemm(const bf16_t* A, const bf16_t* Bt, int M, int N, int K, EpiP ep) {
    __shared__ float As[16][132], Bs[16][132];
    const int tid = threadIdx.x, tx = tid & 15, ty = tid >> 4;
    const int bm = blockIdx.y * 128, bn = blockIdx.x * 128;
    float acc[8][8];
#pragma unroll
    for (int i = 0; i < 8; ++i)
#pragma unroll
        for (int j = 0; j < 8; ++j) acc[i][j] = 0.f;
    const int lr = tid >> 1, lk = (tid & 1) * 8;
    float ratio[8];
    if (MODE == EPI_OUT) {
#pragma unroll
        for (int i = 0; i < 8; ++i) {
            const float* q = ep.ssq + (size_t)(bm + ty * 8 + i) * 16;
            float a = 0.f, b = 0.f;
            for (int h = 0; h < 8; ++h) { a += q[h]; b += q[8 + h]; }
            float ra = rsqrtf(a * (1.f / 512.f) + RMS_EPS), rb = rsqrtf(b * (1.f / 512.f) + RMS_EPS);
            ratio[i] = ra / rb;
        }
    }
    for (int k0 = 0; k0 < K; k0 += 16) {
        if (MODE == EPI_OUT && k0 == 512) {
#pragma unroll
            for (int i = 0; i < 8; ++i)
#pragma unroll
                for (int j = 0; j < 8; ++j) acc[i][j] *= ratio[i];
        }
        {
            const uint4 va = *(const uint4*)(A + (size_t)(bm + lr) * K + k0 + lk);
            const uint4 vb = *(const uint4*)(Bt + (size_t)(bn + lr) * K + k0 + lk);
            const unsigned ua[4] = {va.x, va.y, va.z, va.w}, ub[4] = {vb.x, vb.y, vb.z, vb.w};
#pragma unroll
            for (int i = 0; i < 4; ++i) {
                As[lk + 2 * i][lr] = __uint_as_float(ua[i] << 16); As[lk + 2 * i + 1][lr] = __uint_as_float(ua[i] & 0xffff0000u);
                Bs[lk + 2 * i][lr] = __uint_as_float(ub[i] << 16); Bs[lk + 2 * i + 1][lr] = __uint_as_float(ub[i] & 0xffff0000u);
            }
        }
        __syncthreads();
#pragma unroll
        for (int kk = 0; kk < 16; ++kk) {
            float a[8], b[8];
#pragma unroll
            for (int i = 0; i < 8; ++i) { a[i] = As[kk][ty * 8 + i]; b[i] = Bs[kk][tx * 8 + i]; }
#pragma unroll
            for (int i = 0; i < 8; ++i)
#pragma unroll
                for (int j = 0; j < 8; ++j) acc[i][j] += a[i] * b[j];
        }
        __syncthreads();
    }
#pragma unroll
    for (int i = 0; i < 8; ++i) {
        const int m = bm + ty * 8 + i;
        float rs = 1.f;
        if (MODE == EPI_OUT) {
            const float* q = ep.ssq + (size_t)m * 16; float b = 0.f;
            for (int h = 0; h < 8; ++h) b += q[8 + h];
            rs = rsqrtf(b * (1.f / 512.f) + RMS_EPS);
        }
        if (MODE == EPI_GATE) {
            const float* q = ep.ssq1 + (size_t)m * 4;
            rs = rsqrtf((q[0] + q[1] + q[2] + q[3]) * (1.f / DM) + RMS_EPS);
        }
#pragma unroll
        for (int j = 0; j < 8; ++j) {
            const int n = bn + tx * 8 + j; float v = acc[i][j];
            if (MODE == EPI_PROJ) {
                const int g = n >> 9;
                if (g == 0 || g == 4) v *= C2;
                else if (g == 3 || g == 7) v = v / (1.f + __expf(-v));
                ep.obf[(size_t)m * N + n] = f2bf(v);
            } else if (MODE == EPI_PLE) {
                ep.obf[(size_t)m * N + n] = f2bf(v);
            } else if (MODE == EPI_OUT) {
                ep.obf[(size_t)m * N + n] = f2bf(ep.x[(size_t)m * N + n] + rs * v);
            } else {
                const float gate = 1.f / (1.f + __expf(-rs * v));
                ep.of32[(size_t)m * N + n] = bf2f(ep.x1[(size_t)m * N + n]) + bf2f(ep.ple[(size_t)m * N + n]) * gate;
            }
        }
    }
}

__global__ void nv_ksum(const bf16_t* PROJ, float* KSUM) {
    int blk = blockIdx.x, c = threadIdx.x;
    float s = 0.f;
    for (int r = 0; r < 256; ++r) s += bf2f(PROJ[(size_t)(blk * 256 + r) * NPROJ + 2560 + c]);
    KSUM[(size_t)blk * 1024 + c] = s; KSUM[(size_t)blk * 1024 + 512 + c] = 0.f;
}

__global__ __launch_bounds__(64) void nv_sb(const bf16_t* PROJ, const float* g_sb, bf16_t* Y, float* SSQ) {
    const int bh = blockIdx.y, b = bh >> 3, h = bh & 7, lane = threadIdx.x;
    const int t = blockIdx.x * 64 + lane;
    const size_t row = (size_t)b * SEQ + t;
    float q[64], o[64];
    {
        const bf16_t* qp = PROJ + row * NPROJ + h * 64;
#pragma unroll
        for (int d = 0; d < 64; ++d) { q[d] = bf2f(qp[d]); o[d] = 0.f; }
    }
    float L = 0.f;
    const int smax = blockIdx.x * 64 + 62;
    for (int s = smax; s >= 0; --s) {
        const bf16_t* kp = PROJ + ((size_t)b * SEQ + s) * NPROJ + 512 + h * 64;
        const bf16_t* vp = kp + 512;
        float u = 0.f;
#pragma unroll
        for (int d = 0; d < 64; ++d) u += q[d] * bf2f(kp[d]);
        const float g = __log2f(1.f + exp2f(-fabsf(u)));
        const float l = fmaxf(u, 0.f) + g, ls = fminf(u, 0.f) - g;
        if (s < t) {
            const float w = exp2f(ls - L);
#pragma unroll
            for (int d = 0; d < 64; ++d) o[d] += w * bf2f(vp[d]);
            L += l;
        }
        if (s < blockIdx.x * 64 && __all(L > 200.f)) break;
    }
    float ss = 0.f;
#pragma unroll
    for (int d = 0; d < 64; ++d) ss += o[d] * o[d];
    SSQ[row * 16 + h] = ss;
    const bf16_t* zp = PROJ + row * NPROJ + 1536 + h * 64;
#pragma unroll
    for (int d = 0; d < 64; ++d) Y[row * DM + h * 64 + d] = f2bf(o[d] * bf2f(zp[d]) * g_sb[h * 64 + d]);
}

__global__ __launch_bounds__(64) void nv_moba(const bf16_t* PROJ, const float* KSUM, const float* g_mb, bf16_t* Y, float* SSQ) {
    const int bh = blockIdx.y, b = bh >> 3, h = bh & 7, lane = threadIdx.x;
    const int t = blockIdx.x * 64 + lane, blk = t >> 8;
    const size_t row = (size_t)b * SEQ + t;
    float q[64], o[64];
    {
        const bf16_t* qp = PROJ + row * NPROJ + 2048 + h * 64;
#pragma unroll
        for (int d = 0; d < 64; ++d) { q[d] = bf2f(qp[d]); o[d] = 0.f; }
    }
    float g0 = -INFINITY, g1 = -INFINITY, g2 = -INFINITY; int i0 = -1, i1 = -1, i2 = -1;
    for (int j = 0; j < blk; ++j) {
        const float* ks = KSUM + (size_t)(b * 16 + j) * 1024 + h * 64;
        float g = 0.f;
#pragma unroll
        for (int d = 0; d < 64; ++d) g += q[d] * (ks[d] + ks[512 + d]);
        if (g > g0) { g2 = g1; i2 = i1; g1 = g0; i1 = i0; g0 = g; i0 = j; }
        else if (g > g1) { g2 = g1; i2 = i1; g1 = g; i1 = j; }
        else if (g > g2) { g2 = g; i2 = j; }
    }
    const float slope2 = exp2f(-(float)(h + 1)) * LOG2E;
    float m = -INFINITY, l = 0.f;
    for (int slot = 0; slot < 4; ++slot) {
        const int kb = slot == 0 ? blk : (slot == 1 ? i0 : (slot == 2 ? i1 : i2));
        if (kb < 0) continue;
        for (int kk = 0; kk < 256; ++kk) {
            const int s = kb * 256 + kk;
            if (s > t) break;
            const bf16_t* kp = PROJ + ((size_t)b * SEQ + s) * NPROJ + 2560 + h * 64;
            const bf16_t* vp = kp + 512;
            float sc = 0.f;
#pragma unroll
            for (int d = 0; d < 64; ++d) sc += q[d] * bf2f(kp[d]);
            sc += slope2 * (float)(s - t);
            if (sc > m) {
                const float a = exp2f(m - sc);
                l *= a;
#pragma unroll
                for (int d = 0; d < 64; ++d) o[d] *= a;
                m = sc;
            }
            const float pw = exp2f(sc - m);
            l += pw;
#pragma unroll
            for (int d = 0; d < 64; ++d) o[d] += pw * bf2f(vp[d]);
        }
    }
    const float il = 1.f / l;
    float ss = 0.f;
#pragma unroll
    for (int d = 0; d < 64; ++d) { o[d] *= il; ss += o[d] * o[d]; }
    SSQ[row * 16 + 8 + h] = ss;
    const bf16_t* zp = PROJ + row * NPROJ + 3584 + h * 64;
#pragma unroll
    for (int d = 0; d < 64; ++d) Y[row * DM + 512 + h * 64 + d] = f2bf(o[d] * bf2f(zp[d]) * g_mb[h * 64 + d]);
}

__global__ void nv_ssq1(const bf16_t* X1, float* SSQ1) {
    int row = blockIdx.x * 4 + (threadIdx.x >> 6), lane = threadIdx.x & 63;
    float s = 0.f;
#pragma unroll
    for (int j = 0; j < 16; ++j) { float v = bf2f(X1[(size_t)row * DM + lane + 64 * j]); s += v * v; }
#pragma unroll
    for (int o = 1; o < 64; o <<= 1) s += __shfl_xor(s, o);
    if (lane < 4) SSQ1[(size_t)row * 4 + lane] = lane == 0 ? s : 0.f;
}
__global__ void nv_final_norm(float* out, const float* g) {
    int row = blockIdx.x * 4 + (threadIdx.x >> 6), lane = threadIdx.x & 63;
    float* xr = out + (size_t)row * DM;
    float v[16]; float s = 0.f;
#pragma unroll
    for (int j = 0; j < 16; ++j) { v[j] = xr[lane + 64 * j]; s += v[j] * v[j]; }
#pragma unroll
    for (int o = 1; o < 64; o <<= 1) s += __shfl_xor(s, o);
    float rstd = rsqrtf(s * (1.f / DM) + RMS_EPS);
#pragma unroll
    for (int j = 0; j < 16; ++j) xr[lane + 64 * j] = v[j] * rstd * g[lane + 64 * j];
}

extern "C" void kernel_launch(void* const* d_in, const int* in_sizes, int n_in, void* d_out, int out_size, void* d_ws, size_t ws_size, hipStream_t stream) {
    if (n_in != 11 || in_sizes[0] != MTOK * DM || out_size != MTOK * DM || ws_size < WS_END) {
        fprintf(stderr, "kernel_launch: unexpected shapes n_in %d in0 %d out %d ws %zu\n", n_in, n_in > 0 ? in_sizes[0] : -1, out_size, ws_size);
        return;
    }
    const float* x = (const float*)d_in[0]; const float* p = (const float*)d_in[1]; const float* w_in = (const float*)d_in[2];
    const float* g_mix = (const float*)d_in[3]; const float* g_sb = (const float*)d_in[4]; const float* g_mb = (const float*)d_in[5];
    const float* w_out = (const float*)d_in[6]; const float* w_ple = (const float*)d_in[7]; const float* g_ple = (const float*)d_in[8];
    const float* w_gate = (const float*)d_in[9]; const float* g_final = (const float*)d_in[10];
    unsigned char* ws = (unsigned char*)d_ws; float* out = (float*)d_out;
    bf16_t* WT_IN = (bf16_t*)(ws + WS_WT_IN); bf16_t* WT_OUT = (bf16_t*)(ws + WS_WT_OUT); bf16_t* WT_GATE = (bf16_t*)(ws + WS_WT_GATE); bf16_t* WT_PLE = (bf16_t*)(ws + WS_WT_PLE);
    float* KSUM = (float*)(ws + WS_KSUM); float* SSQ = (float*)(ws + WS_SSQ); float* SSQ1 = (float*)(ws + WS_SSQ1);
    bf16_t* XN = (bf16_t*)(ws + WS_XN); bf16_t* Y = (bf16_t*)(ws + WS_Y); bf16_t* PB = (bf16_t*)(ws + WS_PB); bf16_t* PLE = (bf16_t*)(ws + WS_PLE);
    bf16_t* X1 = (bf16_t*)(ws + WS_X1); bf16_t* PROJ = (bf16_t*)(ws + WS_PROJ);

    nv_transpose_w<<<(DM * NPROJ + 255) / 256, 256, 0, stream>>>(w_in, DM, NPROJ, WT_IN, nullptr);
    nv_transpose_w<<<(DM * DM + 255) / 256, 256, 0, stream>>>(w_out, DM, DM, WT_OUT, nullptr);
    nv_transpose_w<<<(DM * DM + 255) / 256, 256, 0, stream>>>(w_gate, DM, DM, WT_GATE, g_ple);
    nv_transpose_w<<<(DPLE * DM + 255) / 256, 256, 0, stream>>>(w_ple, DPLE, DM, WT_PLE, nullptr);
    nv_rmsnorm_bf16<<<MTOK / 4, 256, 0, stream>>>(x, g_mix, XN);
    nv_cvt_bf16<<<(MTOK * DPLE + 255) / 256, 256, 0, stream>>>(p, PB, (size_t)MTOK * DPLE);
    EpiP ep{};
    ep.obf = PROJ;
    nv_gemm<EPI_PROJ><<<dim3(NPROJ / 128, MTOK / 128), 256, 0, stream>>>(XN, WT_IN, MTOK, NPROJ, DM, ep);
    ep = EpiP{}; ep.obf = PLE;
    nv_gemm<EPI_PLE><<<dim3(DM / 128, MTOK / 128), 256, 0, stream>>>(PB, WT_PLE, MTOK, DM, DPLE, ep);
    nv_ksum<<<MTOK / 256, 512, 0, stream>>>(PROJ, KSUM);
    nv_sb<<<dim3(SEQ / 64, NB * NH), 64, 0, stream>>>(PROJ, g_sb, Y, SSQ);
    nv_moba<<<dim3(SEQ / 64, NB * NH), 64, 0, stream>>>(PROJ, KSUM, g_mb, Y, SSQ);
    ep = EpiP{}; ep.obf = X1; ep.x = x; ep.ssq = SSQ;
    nv_gemm<EPI_OUT><<<dim3(DM / 128, MTOK / 128), 256, 0, stream>>>(Y, WT_OUT, MTOK, DM, DM, ep);
    nv_ssq1<<<MTOK / 4, 256, 0, stream>>>(X1, SSQ1);
    ep = EpiP{}; ep.of32 = out; ep.ssq1 = SSQ1; ep.x1 = X1; ep.ple = PLE;
    nv_gemm<EPI_GATE><<<dim3(DM / 128, MTOK / 128), 256, 0, stream>>>(X1, WT_GATE, MTOK, DM, DM, ep);
    nv_final_norm<<<MTOK / 4, 256, 0, stream>>>(out, g_final);
}
```

```cpp
#include <hip/hip_runtime.h>
#include <cstdio>
#include <cstdint>

typedef unsigned short bf16_t;
#ifndef MK_BUILD
#define MK_BUILD 0x3F
#endif
constexpr int NB = 8, SEQ = 4096, MTOK = NB * SEQ, DM = 1024, NPROJ = 4096, DPLE = 256, NH = 8, HD = 64;
constexpr float RMS_EPS = 1e-6f;
constexpr float LOG2E = 1.4426950408889634f;
constexpr float C2 = 0.125f * LOG2E;

constexpr size_t MiB = 1u << 20;
constexpr size_t WS_CTL = 0, CTL_ZERO_BYTES = 1 * MiB;
constexpr size_t WS_WT_IN = 2 * MiB;
constexpr size_t WS_WT_OUT = 10 * MiB;
constexpr size_t WS_WT_GATE = 12 * MiB;
constexpr size_t WS_WT_PLE = 14 * MiB;
constexpr size_t WS_KSUM = 15 * MiB;
constexpr size_t WS_SSQ = 16 * MiB;
constexpr size_t WS_SSQ1 = 18 * MiB;
constexpr size_t WS_XN = 32 * MiB;
constexpr size_t WS_Y = 32 * MiB;
constexpr size_t WS_PB = 96 * MiB;
constexpr size_t WS_PLE = 112 * MiB;
constexpr size_t WS_X1 = 176 * MiB;
constexpr size_t WS_PROJ = 240 * MiB;
constexpr size_t WS_END = 496 * MiB;

__device__ __forceinline__ float bf2f(bf16_t v) { return __uint_as_float((unsigned)v << 16); }
__device__ __forceinline__ bf16_t f2bf(float f) { unsigned u = __float_as_uint(f); return (bf16_t)((u + 0x7fffu + ((u >> 16) & 1u)) >> 16); }

__global__ void nv_transpose_w(const float* W, int K, int N, bf16_t* WT, const float* rs) {
    size_t i = (size_t)blockIdx.x * blockDim.x + threadIdx.x;
    if (i >= (size_t)K * N) return;
    int n = (int)(i / K), k = (int)(i % K);
    float v = W[(size_t)k * N + n];
    if (rs) v *= rs[k];
    WT[i] = f2bf(v);
}
__global__ void nv_rmsnorm_bf16(const float* x, const float* g, bf16_t* xn) {
    int row = blockIdx.x * 4 + (threadIdx.x >> 6), lane = threadIdx.x & 63;
    const float* xr = x + (size_t)row * DM;
    float v[16]; float s = 0.f;
#pragma unroll
    for (int j = 0; j < 16; ++j) { v[j] = xr[lane + 64 * j]; s += v[j] * v[j]; }
#pragma unroll
    for (int o = 1; o < 64; o <<= 1) s += __shfl_xor(s, o);
    float rstd = rsqrtf(s * (1.f / DM) + RMS_EPS);
#pragma unroll
    for (int j = 0; j < 16; ++j) xn[(size_t)row * DM + lane + 64 * j] = f2bf(v[j] * rstd * g[lane + 64 * j]);
}
__global__ void nv_cvt_bf16(const float* p, bf16_t* o, size_t n) {
    size_t i = (size_t)blockIdx.x * blockDim.x + threadIdx.x;
    if (i < n) o[i] = f2bf(p[i]);
}
struct EpiP { bf16_t* obf; float* of32; const float* x; const float* ssq; const float* ssq1; const bf16_t* x1; const bf16_t* ple; int pad0, pad1; };
enum { EPI_PROJ = 0, EPI_PLE = 1, EPI_OUT = 2, EPI_GATE = 3 };
template <int MODE>
__global__ __launch_bounds__(256) void nv_gemm(const bf16_t* A, const bf16_t* Bt, int M, int N, int K, EpiP ep) {
    __shared__ float As[16][132], Bs[16][132];
    const int tid = threadIdx.x, tx = tid & 15, ty = tid >> 4;
    const int bm = blockIdx.y * 128, bn = blockIdx.x * 128;
    float acc[8][8];
#pragma unroll
    for (int i = 0; i < 8; ++i)
#pragma unroll
        for (int j = 0; j < 8; ++j) acc[i][j] = 0.f;
    const int lr = tid >> 1, lk = (tid & 1) * 8;
    float ratio[8];
    if (MODE == EPI_OUT) {
#pragma unroll
        for (int i = 0; i < 8; ++i) {
            const float* q = ep.ssq + (size_t)(bm + ty * 8 + i) * 16;
            float a = 0.f, b = 0.f;
            for (int h = 0; h < 8; ++h) { a += q[h]; b += q[8 + h]; }
            float ra = rsqrtf(a * (1.f / 512.f) + RMS_EPS), rb = rsqrtf(b * (1.f / 512.f) + RMS_EPS);
            ratio[i] = ra / rb;
        }
    }
    for (int k0 = 0; k0 < K; k0 += 16) {
        if (MODE == EPI_OUT && k0 == 512) {
#pragma unroll
            for (int i = 0; i < 8; ++i)
#pragma unroll
                for (int j = 0; j < 8; ++j) acc[i][j] *= ratio[i];
        }
        {
            const uint4 va = *(const uint4*)(A + (size_t)(bm + lr) * K + k0 + lk);
            const uint4 vb = *(const uint4*)(Bt + (size_t)(bn + lr) * K + k0 + lk);
            const unsigned ua[4] = {va.x, va.y, va.z, va.w}, ub[4] = {vb.x, vb.y, vb.z, vb.w};
#pragma unroll
            for (int i = 0; i < 4; ++i) {
                As[lk + 2 * i][lr] = __uint_as_float(ua[i] << 16); As[lk + 2 * i + 1][lr] = __uint_as_float(ua[i] & 0xffff0000u);
                Bs[lk + 2 * i][lr] = __uint_as_float(ub[i] << 16); Bs[lk + 2 * i + 1][lr] = __uint_as_float(ub[i] & 0xffff0000u);
            }
        }
        __syncthreads();
#pragma unroll
        for (int kk = 0; kk < 16; ++kk) {
            float a[8], b[8];
#pragma unroll
            for (int i = 0; i < 8; ++i) { a[i] = As[kk][ty * 8 + i]; b[i] = Bs[kk][tx * 8 + i]; }
#pragma unroll
            for (int i = 0; i < 8; ++i)
#pragma unroll
                for (int j = 0; j < 8; ++j) acc[i][j] += a[i] * b[j];
        }
        __syncthreads();
    }
#pragma unroll
    for (int i = 0; i < 8; ++i) {
        const int m = bm + ty * 8 + i;
        float rs = 1.f;
        if (MODE == EPI_OUT) {
            const float* q = ep.ssq + (size_t)m * 16; float b = 0.f;
            for (int h = 0; h < 8; ++h) b += q[8 + h];
            rs = rsqrtf(b * (1.f / 512.f) + RMS_EPS);
        }
        if (MODE == EPI_GATE) {
            const float* q = ep.ssq1 + (size_t)m * 16; float b = 0.f;
            for (int h = 0; h < 16; ++h) b += q[h];
            rs = rsqrtf(b * (1.f / DM) + RMS_EPS);
        }
#pragma unroll
        for (int j = 0; j < 8; ++j) {
            const int n = bn + tx * 8 + j; float v = acc[i][j];
            if (MODE == EPI_PROJ) {
                const int g = n >> 9;
                if (g == 0 || g == 4) v *= C2;
                else if (g == 3 || g == 7) v = v / (1.f + __expf(-v));
                ep.obf[(size_t)m * N + n] = f2bf(v);
            } else if (MODE == EPI_PLE) {
                ep.obf[(size_t)m * N + n] = f2bf(v);
            } else if (MODE == EPI_OUT) {
                ep.obf[(size_t)m * N + n] = f2bf(ep.x[(size_t)m * N + n] + rs * v);
            } else {
                const float gate = 1.f / (1.f + __expf(-rs * v));
                ep.of32[(size_t)m * N + n] = bf2f(ep.x1[(size_t)m * N + n]) + bf2f(ep.ple[(size_t)m * N + n]) * gate;
            }
        }
    }
}
__global__ void nv_ksum(const bf16_t* PROJ, float* KSUM) {
    int blk = blockIdx.x, c = threadIdx.x;
    float s = 0.f;
    for (int r = 0; r < 256; ++r) s += bf2f(PROJ[(size_t)(blk * 256 + r) * NPROJ + 2560 + c]);
    KSUM[(size_t)blk * 1024 + c] = s; KSUM[(size_t)blk * 1024 + 512 + c] = 0.f;
}
__global__ __launch_bounds__(64) void nv_sb(const bf16_t* PROJ, const float* g_sb, bf16_t* Y, float* SSQ) {
    const int bh = blockIdx.y, b = bh >> 3, h = bh & 7, lane = threadIdx.x;
    const int t = blockIdx.x * 64 + lane;
    const size_t row = (size_t)b * SEQ + t;
    float q[64], o[64];
    {
        const bf16_t* qp = PROJ + row * NPROJ + h * 64;
#pragma unroll
        for (int d = 0; d < 64; ++d) { q[d] = bf2f(qp[d]); o[d] = 0.f; }
    }
    float L = 0.f;
    const int smax = blockIdx.x * 64 + 62;
    for (int s = smax; s >= 0; --s) {
        const bf16_t* kp = PROJ + ((size_t)b * SEQ + s) * NPROJ + 512 + h * 64;
        const bf16_t* vp = kp + 512;
        float u = 0.f;
#pragma unroll
        for (int d = 0; d < 64; ++d) u += q[d] * bf2f(kp[d]);
        const float g = __log2f(1.f + exp2f(-fabsf(u)));
        const float l = fmaxf(u, 0.f) + g, ls = fminf(u, 0.f) - g;
        if (s < t) {
            const float w = exp2f(ls - L);
#pragma unroll
            for (int d = 0; d < 64; ++d) o[d] += w * bf2f(vp[d]);
            L += l;
        }
        if (s < blockIdx.x * 64 && __all(L > 200.f)) break;
    }
    float ss = 0.f;
#pragma unroll
    for (int d = 0; d < 64; ++d) ss += o[d] * o[d];
    SSQ[row * 16 + h] = ss;
    const bf16_t* zp = PROJ + row * NPROJ + 1536 + h * 64;
#pragma unroll
    for (int d = 0; d < 64; ++d) Y[row * DM + h * 64 + d] = f2bf(o[d] * bf2f(zp[d]) * g_sb[h * 64 + d]);
}
__global__ __launch_bounds__(64) void nv_moba(const bf16_t* PROJ, const float* KSUM, const float* g_mb, bf16_t* Y, float* SSQ) {
    const int bh = blockIdx.y, b = bh >> 3, h = bh & 7, lane = threadIdx.x;
    const int t = blockIdx.x * 64 + lane, blk = t >> 8;
    const size_t row = (size_t)b * SEQ + t;
    float q[64], o[64];
    {
        const bf16_t* qp = PROJ + row * NPROJ + 2048 + h * 64;
#pragma unroll
        for (int d = 0; d < 64; ++d) { q[d] = bf2f(qp[d]); o[d] = 0.f; }
    }
    float g0 = -INFINITY, g1 = -INFINITY, g2 = -INFINITY; int i0 = -1, i1 = -1, i2 = -1;
    for (int j = 0; j < blk; ++j) {
        const float* ks = KSUM + (size_t)(b * 16 + j) * 1024 + h * 64;
        float g = 0.f;
#pragma unroll
        for (int d = 0; d < 64; ++d) g += q[d] * (ks[d] + ks[512 + d]);
        if (g > g0) { g2 = g1; i2 = i1; g1 = g0; i1 = i0; g0 = g; i0 = j; }
        else if (g > g1) { g2 = g1; i2 = i1; g1 = g; i1 = j; }
        else if (g > g2) { g2 = g; i2 = j; }
    }
    const float slope2 = exp2f(-(float)(h + 1)) * LOG2E;
    float m = -INFINITY, l = 0.f;
    for (int slot = 0; slot < 4; ++slot) {
        const int kb = slot == 0 ? blk : (slot == 1 ? i0 : (slot == 2 ? i1 : i2));
        if (kb < 0) continue;
        for (int kk = 0; kk < 256; ++kk) {
            const int s = kb * 256 + kk;
            if (s > t) break;
            const bf16_t* kp = PROJ + ((size_t)b * SEQ + s) * NPROJ + 2560 + h * 64;
            const bf16_t* vp = kp + 512;
            float sc = 0.f;
#pragma unroll
            for (int d = 0; d < 64; ++d) sc += q[d] * bf2f(kp[d]);
            sc += slope2 * (float)(s - t);
            if (sc > m) {
                const float a = exp2f(m - sc);
                l *= a;
#pragma unroll
                for (int d = 0; d < 64; ++d) o[d] *= a;
                m = sc;
            }
            const float pw = exp2f(sc - m);
            l += pw;
#pragma unroll
            for (int d = 0; d < 64; ++d) o[d] += pw * bf2f(vp[d]);
        }
    }
    const float il = 1.f / l;
    float ss = 0.f;
#pragma unroll
    for (int d = 0; d < 64; ++d) { o[d] *= il; ss += o[d] * o[d]; }
    SSQ[row * 16 + 8 + h] = ss;
    const bf16_t* zp = PROJ + row * NPROJ + 3584 + h * 64;
#pragma unroll
    for (int d = 0; d < 64; ++d) Y[row * DM + 512 + h * 64 + d] = f2bf(o[d] * bf2f(zp[d]) * g_mb[h * 64 + d]);
}
__global__ void nv_ssq1(const bf16_t* X1, float* SSQ1) {
    int row = blockIdx.x * 4 + (threadIdx.x >> 6), lane = threadIdx.x & 63;
    float s = 0.f;
#pragma unroll
    for (int j = 0; j < 16; ++j) { float v = bf2f(X1[(size_t)row * DM + lane + 64 * j]); s += v * v; }
#pragma unroll
    for (int o = 1; o < 64; o <<= 1) s += __shfl_xor(s, o);
    if (lane < 16) SSQ1[(size_t)row * 16 + lane] = lane == 0 ? s : 0.f;
}
__global__ void nv_final_norm(float* out, const float* g) {
    int row = blockIdx.x * 4 + (threadIdx.x >> 6), lane = threadIdx.x & 63;
    float* xr = out + (size_t)row * DM;
    float v[16]; float s = 0.f;
#pragma unroll
    for (int j = 0; j < 16; ++j) { v[j] = xr[lane + 64 * j]; s += v[j] * v[j]; }
#pragma unroll
    for (int o = 1; o < 64; o <<= 1) s += __shfl_xor(s, o);
    float rstd = rsqrtf(s * (1.f / DM) + RMS_EPS);
#pragma unroll
    for (int j = 0; j < 16; ++j) xr[lane + 64 * j] = v[j] * rstd * g[lane + 64 * j];
}

namespace pg8 {
#define PG8_LAS __attribute__((address_space(3)))
typedef short bf16x8 __attribute__((ext_vector_type(8)));
typedef float f32x4 __attribute__((ext_vector_type(4)));
typedef float f32x2 __attribute__((ext_vector_type(2)));
typedef unsigned u32x4 __attribute__((ext_vector_type(4)));
constexpr int BM = 256, BK = 64, HALF = 128, HTB = HALF * BK * 2  , STAGE_BYTES = 8 * HTB, NXCD = 8, WGM = 8;

__host__ __device__ __forceinline__ int lds_byte(int r, int c) { const int st = (r >> 4) * 2 + (c >> 5), rr = r & 15, cc = c & 31, ob = rr * 64 + cc * 2; return st * 1024 + (ob ^ (((ob >> 9) & 1) << 5)); }
__host__ __device__ __forceinline__ void stage_rc(int b, int& R, int& C) { const int st = b / 1024, sb = b % 1024, swz = sb ^ (((sb >> 9) & 1) << 5); R = (st >> 1) * 16 + swz / 64; C = (st & 1) * 32 + (swz % 64) / 2; }
__host__ __device__ __forceinline__ int perm32(int rho) { const int n = rho >> 4, i = rho & 15; return 8 * (i >> 2) + 4 * n + (i & 3); }

struct Unit { int pm, pn; };
struct Gemm { const bf16_t* A; const bf16_t* Bt; int M, N, K; };

struct StaticOrder {
    int nM, nN, nwg, G, c;
    __host__ __device__ void init(int M, int N, int G_, int c_) { nM = M / BM; nN = N / BM; nwg = nM * nN; G = G_; c = c_; }
    __host__ __device__ bool next(int i, Unit& u) const {
        const long L = (long)i * G + c; if (L >= nwg) return false;
        int wgid = (int)L; { const int q = nwg / NXCD, r = nwg % NXCD, xcd = wgid % NXCD, off = wgid / NXCD; wgid = (xcd < r ? xcd * (q + 1) : r * (q + 1) + (xcd - r) * q) + off; }
        const int nig = WGM * nN, gid = wgid / nig, fm = gid * WGM, gsz = (nM - fm) < WGM ? (nM - fm) : WGM;
        u.pm = fm + ((wgid % nig) % gsz); u.pn = (wgid % nig) / gsz; return true;
    }
    __device__ __forceinline__ void a_ready(const Unit&) const {}
    __device__ __forceinline__ void done(const Unit&) const {}
};

__device__ __forceinline__ unsigned cvt_pk_bf16(float lo, float hi) { unsigned r; asm volatile("v_cvt_pk_bf16_f32 %0, %1, %2" : "=v"(r) : "v"(lo), "v"(hi)); return r; }
__device__ __forceinline__ u32x4 pack8(const f32x4 v0, const f32x4 v1) { u32x4 w; w.x = cvt_pk_bf16(v0[0], v0[1]); w.y = cvt_pk_bf16(v0[2], v0[3]); w.z = cvt_pk_bf16(v1[0], v1[1]); w.w = cvt_pk_bf16(v1[2], v1[3]); return w; }
__device__ __forceinline__ float silu_f(float v) { return v * __builtin_amdgcn_rcpf(1.f + __builtin_amdgcn_exp2f(-v * LOG2E)); }
__device__ __forceinline__ float sigm_f(float v) { return __builtin_amdgcn_rcpf(1.f + __builtin_amdgcn_exp2f(-v * LOG2E)); }

struct EpiStore {
    static constexpr bool PERM = true, AFTER_DRAIN = false;
    bf16_t* O; int ldc;
    __device__ __forceinline__ void midk(f32x4 (&)[2][2][4][2], int, int, int) const {}
    __device__ __forceinline__ void operator()(const f32x4 (&acc)[2][2][4][2], const Unit& u, int ui, int wr, int wc, int fr, int fq) const {
        const int row0 = u.pm * BM + wr * 64 + fr, col0 = u.pn * BM + wc * 32 + 8 * fq;
#pragma unroll
        for (int ai = 0; ai < 2; ++ai)
#pragma unroll
            for (int m = 0; m < 4; ++m) { bf16_t* rowp = O + (size_t)(row0 + ai * HALF + m * 16) * ldc + col0;
#pragma unroll
                for (int bj = 0; bj < 2; ++bj) *(u32x4*)(rowp + bj * HALF) = pack8(acc[ai][bj][m][0], acc[ai][bj][m][1]); }
    }
};
struct EpiProj {
    static constexpr bool PERM = true, AFTER_DRAIN = false;
    bf16_t* O; float* ksum;
    __device__ __forceinline__ void midk(f32x4 (&)[2][2][4][2], int, int, int) const {}
    __device__ __forceinline__ void operator()(const f32x4 (&acc)[2][2][4][2], const Unit& u, int ui, int wr, int wc, int fr, int fq) const {
        const int row0 = u.pm * BM + wr * 64 + fr, col0 = u.pn * BM + wc * 32 + 8 * fq;
        const int g = u.pn >> 1;
        const bool isq = (g == 0) || (g == 4), isz = (g == 3) || (g == 7);
        const float sc = isq ? C2 : 1.f;
#pragma unroll
        for (int ai = 0; ai < 2; ++ai)
#pragma unroll
            for (int m = 0; m < 4; ++m) { bf16_t* rowp = O + (size_t)(row0 + ai * HALF + m * 16) * NPROJ + col0;
#pragma unroll
                for (int bj = 0; bj < 2; ++bj) { f32x4 v0 = acc[ai][bj][m][0] * sc, v1 = acc[ai][bj][m][1] * sc;
                    if (isz) {
#pragma unroll
                        for (int j = 0; j < 4; ++j) { v0[j] = silu_f(v0[j]); v1[j] = silu_f(v1[j]); } }
                    *(u32x4*)(rowp + bj * HALF) = pack8(v0, v1); } }
        if (g == 5) {
            float* kp = ksum + (size_t)(u.pm * 2 + wr) * 512 + (u.pn * BM - 2560) + wc * 32 + 8 * fq;
#pragma unroll
            for (int bj = 0; bj < 2; ++bj)
#pragma unroll
                for (int n = 0; n < 2; ++n) { f32x4 s = (f32x4){0.f, 0.f, 0.f, 0.f};
#pragma unroll
                    for (int ai = 0; ai < 2; ++ai)
#pragma unroll
                        for (int m = 0; m < 4; ++m) s += acc[ai][bj][m][n];
#pragma unroll
                    for (int j = 0; j < 4; ++j) { float v = s[j]; v += __shfl_xor(v, 1); v += __shfl_xor(v, 2); v += __shfl_xor(v, 4); v += __shfl_xor(v, 8); s[j] = v; }
                    if (fr == 0) *(f32x4*)(kp + bj * HALF + 4 * n) = s; }
        }
    }
};
struct EpiOut {
    static constexpr bool PERM = true, AFTER_DRAIN = false;
    const float* x; bf16_t* X1; float* ssq1; const PG8_LAS f32x2* tab;
    __device__ __forceinline__ void midk(f32x4 (&acc)[2][2][4][2], int ui, int wr, int fr) const {
#pragma unroll
        for (int ai = 0; ai < 2; ++ai)
#pragma unroll
            for (int m = 0; m < 4; ++m) { const float f = tab[ui * 256 + ai * HALF + wr * 64 + m * 16 + fr].x;
#pragma unroll
                for (int bj = 0; bj < 2; ++bj)
#pragma unroll
                    for (int n = 0; n < 2; ++n) acc[ai][bj][m][n] *= f; }
    }
    __device__ __forceinline__ void operator()(const f32x4 (&acc)[2][2][4][2], const Unit& u, int ui, int wr, int wc, int fr, int fq) const {
        const int col0 = u.pn * BM + wc * 32 + 8 * fq;
#pragma unroll
        for (int ai = 0; ai < 2; ++ai)
#pragma unroll
            for (int m = 0; m < 4; ++m) { const int r = ai * HALF + wr * 64 + m * 16 + fr; const float rs = tab[ui * 256 + r].y;
                const size_t off = (size_t)(u.pm * BM + r) * DM + col0; float ss = 0.f;
#pragma unroll
                for (int bj = 0; bj < 2; ++bj) { const f32x4 a0 = *(const f32x4*)(x + off + bj * HALF), a1 = *(const f32x4*)(x + off + bj * HALF + 4);
                    const f32x4 v0 = a0 + acc[ai][bj][m][0] * rs, v1 = a1 + acc[ai][bj][m][1] * rs;
                    ss += (v0[0] * v0[0] + v0[1] * v0[1]) + (v0[2] * v0[2] + v0[3] * v0[3]) + (v1[0] * v1[0] + v1[1] * v1[1]) + (v1[2] * v1[2] + v1[3] * v1[3]);
                    *(u32x4*)(X1 + off + bj * HALF) = pack8(v0, v1); }
                ss += __shfl_xor(ss, 16); ss += __shfl_xor(ss, 32);
                if (fq == 0) ssq1[(size_t)(u.pm * BM + r) * 16 + u.pn * 4 + wc] = ss;
                if (m & 1) asm volatile("" ::: "memory"); }
    }
};
struct EpiGate {
    static constexpr bool PERM = true, AFTER_DRAIN = false;
    const bf16_t* X1; const bf16_t* PLE; float* out; const PG8_LAS f32x2* tab;
    __device__ __forceinline__ void midk(f32x4 (&)[2][2][4][2], int, int, int) const {}
    __device__ __forceinline__ void operator()(const f32x4 (&acc)[2][2][4][2], const Unit& u, int ui, int wr, int wc, int fr, int fq) const {
        const int col0 = u.pn * BM + wc * 32 + 8 * fq;
#pragma unroll
        for (int ai = 0; ai < 2; ++ai)
#pragma unroll
            for (int m = 0; m < 4; ++m) { const int r = ai * HALF + wr * 64 + m * 16 + fr; const float rs = tab[ui * 256 + r].x;
                const size_t off = (size_t)(u.pm * BM + r) * DM + col0;
#pragma unroll
                for (int bj = 0; bj < 2; ++bj) { const u32x4 xa = *(const u32x4*)(X1 + off + bj * HALF), pa = *(const u32x4*)(PLE + off + bj * HALF);
                    f32x4 o0, o1;
#pragma unroll
                    for (int j = 0; j < 2; ++j) {
                        o0[2 * j]     = __uint_as_float(xa[j] << 16)             + __uint_as_float(pa[j] << 16)             * sigm_f(rs * acc[ai][bj][m][0][2 * j]);
                        o0[2 * j + 1] = __uint_as_float(xa[j] & 0xffff0000u)     + __uint_as_float(pa[j] & 0xffff0000u)     * sigm_f(rs * acc[ai][bj][m][0][2 * j + 1]);
                        o1[2 * j]     = __uint_as_float(xa[2 + j] << 16)         + __uint_as_float(pa[2 + j] << 16)         * sigm_f(rs * acc[ai][bj][m][1][2 * j]);
                        o1[2 * j + 1] = __uint_as_float(xa[2 + j] & 0xffff0000u) + __uint_as_float(pa[2 + j] & 0xffff0000u) * sigm_f(rs * acc[ai][bj][m][1][2 * j + 1]); }
                    *(f32x4*)(out + off + bj * HALF) = o0; *(f32x4*)(out + off + bj * HALF + 4) = o1; }
                if (m & 1) asm volatile("" ::: "memory"); }
    }
};

template <class Epi, class Sched, bool ALIGN_EPI = false, bool SP2 = false, bool MIDK = false>
__device__ __forceinline__ void gemm_phase(PG8_LAS unsigned char* lds, const Gemm g, const Sched& S, const Epi& E, const int wid) {
    const int lane = (int)__builtin_amdgcn_mbcnt_hi(~0u, __builtin_amdgcn_mbcnt_lo(~0u, 0u)), tid = wid * 64 + lane, wr = wid >> 2, wc = wid & 3, fr = lane & 15, fq = lane >> 4;
    const int K = g.K, nt = K / BK;
    unsigned voffA[2], voffB[2];
#pragma unroll
    for (int i = 0; i < 2; ++i) { int R, C; stage_rc(tid * 16 + i * 8192, R, C); const int Rb = Epi::PERM ? ((R & ~31) + perm32(R & 31)) : R;
        voffA[i] = (unsigned)(R * K + C) * 2u; voffB[i] = (unsigned)(Rb * K + C) * 2u; }
    const size_t kstep = (size_t)(BK * 2);
    const size_t hstep = (size_t)HALF * K * 2;
    const size_t tstep = 2 * hstep;
    const unsigned ldsw = (unsigned)wid * 1024u;
    const int aoff = lds_byte(wr * 64 + fr, fq * 8), boff = lds_byte(wc * 32 + fr, fq * 8);
#define PG8_SA(b, h) (((b) * 2 + (h)) * HTB)
#define PG8_SB(b, h) ((4 + (b) * 2 + (h)) * HTB)
#define PG8_STAGE(bufoff, gbase, voff) do { _Pragma("unroll") for (int _i = 0; _i < 2; ++_i) \
        __builtin_amdgcn_global_load_lds((const unsigned*)((const char*)(gbase) + (voff)[_i]), (PG8_LAS unsigned*)(lds + (bufoff) + ldsw + _i * 8192), 16, 0, 0); } while (0)
#define PG8_LDA(dst, b, h) do { _Pragma("unroll") for (int m = 0; m < 4; ++m) _Pragma("unroll") for (int k = 0; k < 2; ++k) dst[m][k] = *(const PG8_LAS bf16x8*)(lds + PG8_SA(b, h) + aoff + m * 2048 + k * 1024); } while (0)
#define PG8_LDB(dst, b, h) do { _Pragma("unroll") for (int n = 0; n < 2; ++n) _Pragma("unroll") for (int k = 0; k < 2; ++k) dst[n][k] = *(const PG8_LAS bf16x8*)(lds + PG8_SB(b, h) + boff + n * 2048 + k * 1024); } while (0)
#define PG8_MMA(ai, bj, At, Bt) do { __builtin_amdgcn_s_setprio(1); _Pragma("unroll") for (int m = 0; m < 4; ++m) _Pragma("unroll") for (int n = 0; n < 2; ++n) _Pragma("unroll") for (int k = 0; k < 2; ++k) \
        acc[ai][bj][m][n] = __builtin_amdgcn_mfma_f32_16x16x32_bf16(Bt[n][k], At[m][k], acc[ai][bj][m][n], 0, 0, 0); __builtin_amdgcn_s_setprio(0); } while (0)
#define PG8_WAIT_V(n) asm volatile("s_waitcnt vmcnt(" #n ")" ::: "memory")
#define PG8_WAIT_L(n) asm volatile("s_waitcnt lgkmcnt(" #n ")" ::: "memory")
#define PG8_BAR __builtin_amdgcn_s_barrier()
#define PG8_SCHED __builtin_amdgcn_sched_barrier(0)
    Unit cur, nxt; int ui = 0;
    if (!S.next(0, cur)) return;
    f32x4 acc[2][2][4][2];
#pragma unroll
    for (int a = 0; a < 2; ++a)
#pragma unroll
        for (int b = 0; b < 2; ++b)
#pragma unroll
            for (int m = 0; m < 4; ++m)
#pragma unroll
                for (int n = 0; n < 2; ++n) acc[a][b][m][n] = (f32x4){0.f, 0.f, 0.f, 0.f};
    bf16x8 At[4][2], B0[2][2], B1[2][2];
    const char* cA = (const char*)g.A + (size_t)cur.pm * tstep; const char* cB = (const char*)g.Bt + (size_t)cur.pn * tstep;
    S.a_ready(cur);
    if constexpr (SP2) {
        PG8_STAGE(PG8_SB(0, 0), cB, voffB); PG8_STAGE(PG8_SB(0, 1), cB + hstep, voffB); PG8_STAGE(PG8_SA(0, 0), cA, voffA); PG8_STAGE(PG8_SA(0, 1), cA + hstep, voffA);
        if (wr == 1) PG8_BAR;
        PG8_WAIT_V(2); PG8_BAR;
        PG8_STAGE(PG8_SB(1, 0), cB + kstep, voffB); PG8_STAGE(PG8_SA(1, 0), cA + kstep, voffA); PG8_STAGE(PG8_SB(1, 1), cB + hstep + kstep, voffB);
        PG8_WAIT_V(6); PG8_BAR;
    } else {
        PG8_STAGE(PG8_SB(0, 0), cB, voffB); PG8_STAGE(PG8_SA(0, 0), cA, voffA); PG8_STAGE(PG8_SB(0, 1), cB + hstep, voffB); PG8_STAGE(PG8_SA(0, 1), cA + hstep, voffA);
        if (wr == 1) PG8_BAR;
        PG8_WAIT_V(4); PG8_BAR;
        PG8_STAGE(PG8_SB(1, 0), cB + kstep, voffB); PG8_STAGE(PG8_SA(1, 0), cA + kstep, voffA); PG8_STAGE(PG8_SB(1, 1), cB + hstep + kstep, voffB);
        PG8_WAIT_V(6); PG8_BAR;
    }
    for (;;) {
        const bool has_next = S.next(ui + 1, nxt);
        const char* nA = has_next ? (const char*)g.A + (size_t)nxt.pm * tstep : cA; const char* nB = has_next ? (const char*)g.Bt + (size_t)nxt.pn * tstep : cB;
        for (int t = 0; t < nt; t += 2) {
            const bool last = (t == nt - 2);
            if constexpr (MIDK) { if (t == (nt >> 1)) E.midk(acc, ui, wr, fr); }
            const char* a1 = cA + (size_t)(t + 1) * kstep;
            const char* a2 = last ? nA : cA + (size_t)(t + 2) * kstep; const char* b2 = last ? nB : cB + (size_t)(t + 2) * kstep;
            const char* a3 = a2 + kstep; const char* b3 = b2 + kstep;
            if (last && has_next) S.a_ready(nxt);
            if constexpr (SP2) {
            PG8_LDB(B0, 0, 0); PG8_LDB(B1, 0, 1); PG8_SCHED; PG8_LDA(At, 0, 0); PG8_STAGE(PG8_SA(1, 1), a1 + hstep, voffA);
            PG8_WAIT_V(8); PG8_WAIT_L(0); PG8_BAR; PG8_MMA(0, 0, At, B0); PG8_MMA(0, 1, At, B1); PG8_BAR; PG8_SCHED;
            PG8_LDA(At, 0, 1); PG8_STAGE(PG8_SB(0, 0), b2, voffB); PG8_STAGE(PG8_SB(0, 1), b2 + hstep, voffB); PG8_STAGE(PG8_SA(0, 0), a2, voffA);
            PG8_WAIT_V(8); PG8_WAIT_L(0); PG8_BAR; PG8_MMA(1, 0, At, B0); PG8_MMA(1, 1, At, B1); PG8_BAR; PG8_SCHED;
            PG8_LDB(B0, 1, 0); PG8_LDB(B1, 1, 1); PG8_SCHED; PG8_LDA(At, 1, 0); PG8_STAGE(PG8_SA(0, 1), a2 + hstep, voffA);
            PG8_WAIT_V(8); PG8_WAIT_L(0); PG8_BAR; PG8_MMA(0, 0, At, B0); PG8_MMA(0, 1, At, B1); PG8_BAR; PG8_SCHED;
            PG8_LDA(At, 1, 1); PG8_STAGE(PG8_SB(1, 0), b3, voffB); PG8_STAGE(PG8_SB(1, 1), b3 + hstep, voffB); PG8_STAGE(PG8_SA(1, 0), a3, voffA);
            PG8_WAIT_V(8); PG8_WAIT_L(0); PG8_BAR; PG8_MMA(1, 0, At, B0); PG8_MMA(1, 1, At, B1); PG8_BAR; PG8_SCHED;
            } else {
            PG8_LDB(B0, 0, 0); PG8_SCHED; PG8_LDA(At, 0, 0); PG8_STAGE(PG8_SA(1, 1), a1 + hstep, voffA);
            PG8_WAIT_L(8); PG8_BAR; PG8_WAIT_L(0); PG8_MMA(0, 0, At, B0); PG8_BAR; PG8_SCHED;
            PG8_LDB(B1, 0, 1); PG8_STAGE(PG8_SB(0, 0), b2, voffB);
            PG8_BAR; PG8_WAIT_L(0); PG8_MMA(0, 1, At, B1); PG8_BAR;
            PG8_LDA(At, 0, 1); PG8_STAGE(PG8_SA(0, 0), a2, voffA);
            PG8_BAR; PG8_WAIT_L(0); PG8_MMA(1, 0, At, B0); PG8_BAR; PG8_SCHED;
            PG8_STAGE(PG8_SB(0, 1), b2 + hstep, voffB);
            PG8_WAIT_V(6); PG8_BAR; PG8_MMA(1, 1, At, B1); PG8_BAR;
            PG8_LDB(B0, 1, 0); PG8_SCHED; PG8_LDA(At, 1, 0); PG8_STAGE(PG8_SA(0, 1), a2 + hstep, voffA);
            PG8_WAIT_L(8); PG8_BAR; PG8_WAIT_L(0); PG8_MMA(0, 0, At, B0); PG8_BAR; PG8_SCHED;
            PG8_LDB(B1, 1, 1); PG8_STAGE(PG8_SB(1, 0), b3, voffB);
            PG8_BAR; PG8_WAIT_L(0); PG8_MMA(0, 1, At, B1); PG8_BAR;
            PG8_LDA(At, 1, 1); PG8_STAGE(PG8_SA(1, 0), a3, voffA);
            PG8_BAR; PG8_WAIT_L(0); PG8_MMA(1, 0, At, B0); PG8_BAR; PG8_SCHED;
            PG8_STAGE(PG8_SB(1, 1), b3 + hstep, voffB);
            PG8_WAIT_V(6); PG8_BAR; PG8_MMA(1, 1, At, B1); PG8_BAR;
            }
        }
        if constexpr (ALIGN_EPI) { if (wr == 0) PG8_BAR; }
        if constexpr (!Epi::AFTER_DRAIN) { E(acc, cur, ui, wr, wc, fr, fq); S.done(cur); }
        if (!has_next) break;
#pragma unroll
        for (int a = 0; a < 2; ++a)
#pragma unroll
            for (int b = 0; b < 2; ++b)
#pragma unroll
                for (int m = 0; m < 4; ++m)
#pragma unroll
                    for (int n = 0; n < 2; ++n) acc[a][b][m][n] = (f32x4){0.f, 0.f, 0.f, 0.f};
        cur = nxt; cA = nA; cB = nB; ++ui;
        if constexpr (ALIGN_EPI) { if (wr == 1) PG8_BAR; }
    }
    PG8_WAIT_V(0);
    if constexpr (!ALIGN_EPI) { if (wr == 0) PG8_BAR; }
    PG8_BAR;
    if constexpr (Epi::AFTER_DRAIN) { E.fused(acc, cur, ui, wr, wc, fr, fq, lds, wid, lane); S.done(cur); }
#undef PG8_SA
#undef PG8_SB
#undef PG8_STAGE
#undef PG8_LDA
#undef PG8_LDB
#undef PG8_MMA
#undef PG8_WAIT_V
#undef PG8_WAIT_L
#undef PG8_BAR
#undef PG8_SCHED
}}

constexpr int NWAVES = 8;
constexpr int CW_TMO = 0, CW_CODE = 1;
constexpr int CW_BAR = 4096;
constexpr int RING_OFF = 0, RING_BYTES = 131072;
constexpr int LDSCTL_OFF = RING_BYTES, MISC_OFF = LDSCTL_OFF + 320;
constexpr int TAB_OFF = LDSCTL_OFF + 1024;
constexpr int LDS_BYTES = 147456;
static_assert(TAB_OFF + 4096 <= LDS_BYTES, "LDS map");

#define GAS __attribute__((address_space(1)))
#define LAS __attribute__((address_space(3)))
typedef unsigned short bf16;
typedef unsigned v4u __attribute__((ext_vector_type(4)));
typedef float f32x4 __attribute__((ext_vector_type(4)));
typedef short bf16x8 __attribute__((ext_vector_type(8)));
typedef GAS unsigned gu32;
typedef GAS unsigned long long gu64;
#define RLX_AGENT __ATOMIC_RELAXED, __HIP_MEMORY_SCOPE_AGENT
#define LDS_WAIT() asm volatile("s_waitcnt lgkmcnt(0)" ::: "memory")
#define VM_WAIT() asm volatile("s_waitcnt vmcnt(0)" ::: "memory")
__device__ __forceinline__ unsigned long long rt() { return __builtin_amdgcn_s_memrealtime(); }
__device__ __forceinline__ unsigned f2bf_u(float f) { unsigned u = __builtin_bit_cast(unsigned, f); return (u + 0x7fffu + ((u >> 16) & 1u)) >> 16; }
__device__ __forceinline__ unsigned pk2(float lo, float hi) { return f2bf_u(lo) | (f2bf_u(hi) << 16); }

#define XB_TMO      128
#define XB_XCNT(j)  (256  + 64 * (j))
#define XB_XSUB(j)  (1280 + 64 * (j))
#define XB_XGEN(j)  (2304 + 64 * (j))
#define XB_TOP      3328
#define XB_TOPGEN   3392
#define XCD_BAR_WORDS 3456
#define XB_SPIN_CAP (1u << 18)

__device__ __forceinline__ unsigned xb_ld(unsigned* p)              { return __hip_atomic_load(p, __ATOMIC_RELAXED, __HIP_MEMORY_SCOPE_AGENT); }
__device__ __forceinline__ unsigned xb_add(unsigned* p, unsigned v) { return __hip_atomic_fetch_add(p, v, __ATOMIC_RELAXED, __HIP_MEMORY_SCOPE_AGENT); }
__device__ __forceinline__ unsigned xb_xcc_id() { return (unsigned)__builtin_amdgcn_s_getreg((3 << 11) | 20) & 0xFu; }
#define XB_SPIN(cond, bar) do { unsigned _sp = 0; while (cond) { __builtin_amdgcn_s_sleep(1); \
    if ((++_sp & 255u) == 0u) { if (xb_ld(&(bar)[XB_TMO])) break; if (_sp > XB_SPIN_CAP) { atomicAdd(&(bar)[XB_TMO], 1u); break; } } } } while (0)

struct XcdBarrier {
    unsigned* bar; unsigned x;
    volatile LAS unsigned* st;
};

__device__ __forceinline__ XcdBarrier xcd_barrier_post(unsigned* bar, volatile LAS unsigned* st) {
    XcdBarrier b; b.bar = bar; b.x = xb_xcc_id(); b.st = st;
    if (threadIdx.x == 0) (void)xb_add(&bar[XB_XCNT(b.x)], 1u);
    return b;
}
__device__ __forceinline__ void xcd_barrier_complete(unsigned* bar, unsigned x, unsigned& nloc, unsigned& nx) {
    const unsigned G = gridDim.x * gridDim.y * gridDim.z;
    unsigned sum, cnt, mine, sp = 0u;
    for (;;) {
        sum = 0u; cnt = 0u; mine = 0u;
#pragma unroll
        for (unsigned j = 0; j < 16; ++j) { const unsigned c = xb_ld(&bar[XB_XCNT(j)]); sum += c; cnt += (c > 0u) ? 1u : 0u; mine = (j == x) ? c : mine; }
        if (sum == G) break;
        __builtin_amdgcn_s_sleep(1);
        if ((++sp & 255u) == 0u) { if (xb_ld(&bar[XB_TMO])) break; if (sp > XB_SPIN_CAP) { atomicAdd(&bar[XB_TMO], 1u); break; } }
    }
    nloc = mine > 0u ? mine : 1u; nx = cnt > 0u ? cnt : 1u;
}

__device__ __forceinline__ void xcd_barrier(const XcdBarrier& b) {
    asm volatile("s_waitcnt vmcnt(0)" ::: "memory");
    __syncthreads();
    if (threadIdx.x == 0) {
        unsigned* bar = b.bar;
        __builtin_amdgcn_s_waitcnt(0);
        unsigned nloc = b.st[0], nx = b.st[1];
        if (nloc == 0u) { xcd_barrier_complete(bar, b.x, nloc, nx); b.st[0] = nloc; b.st[1] = nx; }
        const unsigned old = xb_add(&bar[XB_XSUB(b.x)], 1u);
        const unsigned gen = old / nloc;
        if (old + 1u == (gen + 1u) * nloc) {
            __builtin_amdgcn_fence(__ATOMIC_RELEASE, "agent");
            asm volatile("s_waitcnt vmcnt(0)" ::: "memory");
            const unsigned og = xb_add(&bar[XB_TOP], 1u);
            const unsigned tg = og / nx;
            if (og + 1u == (tg + 1u) * nx) xb_add(&bar[XB_TOPGEN], 1u);
            else XB_SPIN(xb_ld(&bar[XB_TOPGEN]) == tg, bar);
            __builtin_amdgcn_fence(__ATOMIC_ACQUIRE, "agent");
            xb_add(&bar[XB_XGEN(b.x)], 1u);
            asm volatile("s_waitcnt vmcnt(0)" ::: "memory");
        } else {
            XB_SPIN(xb_ld(&bar[XB_XGEN(b.x)]) == gen, bar);
            __builtin_amdgcn_fence(__ATOMIC_ACQUIRE, "agent");
            asm volatile("s_waitcnt vmcnt(0)" ::: "memory");
        }
    }
    __syncthreads();
}

struct Frame {
    LAS unsigned char* lds;
    volatile LAS unsigned* MISC;
    gu32* ctl;
    int wave;
    int vcu, G;
};
#define LANE_ID() ((int)__builtin_amdgcn_mbcnt_hi(~0u, __builtin_amdgcn_mbcnt_lo(~0u, 0u)))
__device__ __forceinline__ float wave_sum(float v) {
#pragma unroll
    for (int o = 1; o < 64; o <<= 1) v += __shfl_xor(v, o);
    return v;
}
__device__ __forceinline__ void p0_transpose_item(const float* W, int K, int N, bf16* WT, const float* rs, LAS float* scr, int item, int lane) {
    const int nblk = N / 32, kb = item / nblk, nb = item % nblk, k0 = 64 * kb, n0 = 32 * nb;
#pragma unroll 8
    for (int i = 0; i < 32; ++i) { const int kk = 2 * i + (lane >> 5); float v = W[(size_t)(k0 + kk) * N + n0 + (lane & 31)]; if (rs) v *= rs[k0 + kk]; scr[kk * 33 + (lane & 31)] = v; }
    LDS_WAIT(); asm volatile("" ::: "memory");
    const int c = lane & 7;
#pragma unroll
    for (int j = 0; j < 4; ++j) { const int n = (lane >> 3) + 8 * j; const LAS float* s = scr + (8 * c) * 33 + n;
        v4u o; o.x = pk2(s[0 * 33], s[1 * 33]); o.y = pk2(s[2 * 33], s[3 * 33]); o.z = pk2(s[4 * 33], s[5 * 33]); o.w = pk2(s[6 * 33], s[7 * 33]);
        *(GAS v4u*)(WT + (size_t)(n0 + n) * K + k0 + 8 * c) = o; }
    LDS_WAIT(); asm volatile("" ::: "memory");
}
__device__ __forceinline__ void rms_row_to_bf16(const float* xrow, const float* g, bf16* orow, int lane) {
    const GAS f32x4* xr = (const GAS f32x4*)xrow + lane; const GAS f32x4* gr = (const GAS f32x4*)g + lane;
    f32x4 v[4]; float s = 0.f;
#pragma unroll
    for (int j = 0; j < 4; ++j) { v[j] = xr[64 * j]; s += (v[j].x * v[j].x + v[j].y * v[j].y) + (v[j].z * v[j].z + v[j].w * v[j].w); }
    const float rstd = 1.f / sqrtf(wave_sum(s) * (1.f / DM) + RMS_EPS);
    GAS unsigned long long* o8 = (GAS unsigned long long*)orow + lane;
#pragma unroll
    for (int j = 0; j < 4; ++j) { const f32x4 gg = gr[64 * j]; o8[64 * j] = (unsigned long long)pk2(v[j].x * rstd * gg.x, v[j].y * rstd * gg.y) | ((unsigned long long)pk2(v[j].z * rstd * gg.z, v[j].w * rstd * gg.w) << 32); }
}
__device__ __forceinline__ void final_norm_row(float* xrow, const float* g, int lane) {
    GAS f32x4* xr = (GAS f32x4*)xrow + lane; const GAS f32x4* gr = (const GAS f32x4*)g + lane;
    f32x4 v[4]; float s = 0.f;
#pragma unroll
    for (int j = 0; j < 4; ++j) { v[j] = xr[64 * j]; s += (v[j].x * v[j].x + v[j].y * v[j].y) + (v[j].z * v[j].z + v[j].w * v[j].w); }
    const float rstd = 1.f / sqrtf(wave_sum(s) * (1.f / DM) + RMS_EPS);
#pragma unroll
    for (int j = 0; j < 4; ++j) { const f32x4 gg = gr[64 * j]; xr[64 * j] = v[j] * rstd * gg; }
}

struct Args { const float* in[11]; float* out; unsigned char* ws; int ph_lo, ph_hi, li, pad; };
__global__ void __launch_bounds__(NWAVES * 64, 2) mk_fwd(Args args) {
    extern __shared__ __attribute__((aligned(16))) unsigned char lds[];
    Frame F;
    F.lds = (LAS unsigned char*)lds;
    F.MISC = (volatile LAS unsigned*)(F.lds + MISC_OFF);
    F.wave = __builtin_amdgcn_readfirstlane((int)(threadIdx.x >> 6));
    F.G = gridDim.x; { const int bx = blockIdx.x; F.vcu = (F.G % 8 == 0) ? (bx % 8) * (F.G / 8) + bx / 8 : bx; }
    unsigned char* ws = args.ws;
    F.ctl = (gu32*)(ws + WS_CTL);
    const float* x = args.in[0]; const float* p = args.in[1]; const float* w_in = args.in[2]; const float* g_mix = args.in[3];
    const float* w_out = args.in[6]; const float* w_ple = args.in[7]; const float* g_ple = args.in[8]; const float* w_gate = args.in[9]; const float* g_final = args.in[10];
    float* out = args.out;
    bf16* WT_IN = (bf16*)(ws + WS_WT_IN); bf16* WT_OUT = (bf16*)(ws + WS_WT_OUT); bf16* WT_GATE = (bf16*)(ws + WS_WT_GATE); bf16* WT_PLE = (bf16*)(ws + WS_WT_PLE);
    float* KSUM = (float*)(ws + WS_KSUM); float* SSQ = (float*)(ws + WS_SSQ); float* SSQ1 = (float*)(ws + WS_SSQ1);
    bf16* XN = (bf16*)(ws + WS_XN); bf16* Y = (bf16*)(ws + WS_Y); bf16* PB = (bf16*)(ws + WS_PB); bf16* PLE = (bf16*)(ws + WS_PLE);
    bf16* X1 = (bf16*)(ws + WS_X1); bf16* PROJ = (bf16*)(ws + WS_PROJ);
    for (int u = threadIdx.x; u < (LDS_BYTES - LDSCTL_OFF) / 4; u += NWAVES * 64) ((LAS unsigned*)(F.lds + LDSCTL_OFF))[u] = 0u;
    __syncthreads();
    XcdBarrier bar = xcd_barrier_post((unsigned*)(F.ctl + CW_BAR) + args.li * XCD_BAR_WORDS, F.MISC + 8);
    const int lo = args.ph_lo, hi = args.ph_hi;
#define IN(k) (lo <= (k) && (k) < hi)
#define BOTH(k) (IN(k) && IN((k) + 1))
    const int gw = F.vcu * NWAVES + F.wave, NGW = F.G * NWAVES;
    LAS pg8::f32x2* tab = (LAS pg8::f32x2*)(F.lds + TAB_OFF);

    if (((MK_BUILD >> 0) & 1) && IN(0)) {
        LAS float* scr = (LAS float*)(F.lds + RING_OFF + F.wave * 16384);
        constexpr int I_IN = (DM / 64) * (NPROJ / 32), I_SQ = (DM / 64) * (DM / 32), I_PLE = (DPLE / 64) * (DM / 32);
        constexpr int NITEMS = I_IN + 2 * I_SQ + I_PLE;
        for (int it = gw; it < NITEMS; it += NGW) {
            int r = it;
            if (r < I_IN) { p0_transpose_item(w_in, DM, NPROJ, WT_IN, nullptr, scr, r, LANE_ID()); continue; } r -= I_IN;
            if (r < I_SQ) { p0_transpose_item(w_out, DM, DM, WT_OUT, nullptr, scr, r, LANE_ID()); continue; } r -= I_SQ;
            if (r < I_SQ) { p0_transpose_item(w_gate, DM, DM, WT_GATE, g_ple, scr, r, LANE_ID()); continue; } r -= I_SQ;
            p0_transpose_item(w_ple, DPLE, DM, WT_PLE, nullptr, scr, r, LANE_ID());
        }
        for (int m = gw; m < MTOK; m += NGW) {
            rms_row_to_bf16(x + (size_t)m * DM, g_mix, XN + (size_t)m * DM, LANE_ID());
            const f32x4 pv = ((const GAS f32x4*)(p + (size_t)m * DPLE))[LANE_ID()];
            ((GAS unsigned long long*)(PB + (size_t)m * DPLE))[LANE_ID()] = (unsigned long long)pk2(pv.x, pv.y) | ((unsigned long long)pk2(pv.z, pv.w) << 32);
        }
        if (BOTH(0)) xcd_barrier(bar);
    }
    if (((MK_BUILD >> 1) & 1) && IN(1)) {
        { pg8::Gemm g{XN, WT_IN, MTOK, NPROJ, DM}; pg8::StaticOrder S; S.init(MTOK, NPROJ, F.G, (int)blockIdx.x);
          pg8::EpiProj E{PROJ, KSUM};
          pg8::gemm_phase<pg8::EpiProj, pg8::StaticOrder, true, true, false>(F.lds + RING_OFF, g, S, E, F.wave); }
        { pg8::Gemm g{PB, WT_PLE, MTOK, DM, DPLE}; pg8::StaticOrder S; S.init(MTOK, DM, F.G, (int)blockIdx.x);
          pg8::EpiStore E{PLE, DM};
          pg8::gemm_phase<pg8::EpiStore, pg8::StaticOrder, true, true, false>(F.lds + RING_OFF, g, S, E, F.wave); }
        if (BOTH(1)) xcd_barrier(bar);
    }
    if (((MK_BUILD >> 2) & 1) && IN(2)) {
        if (BOTH(2)) xcd_barrier(bar);
    }
    if (((MK_BUILD >> 3) & 1) && IN(3)) {
        pg8::Gemm g{Y, WT_OUT, MTOK, DM, DM}; pg8::StaticOrder S; S.init(MTOK, DM, F.G, (int)blockIdx.x);
        { pg8::Unit uu; const int tid_ = F.wave * 64 + LANE_ID(); const int un = tid_ >> 8, r = tid_ & 255;
          if (S.next(un, uu)) { const GAS f32x4* q = (const GAS f32x4*)(SSQ + (size_t)(uu.pm * 256 + r) * 16);
              const f32x4 a0 = q[0], a1 = q[1], b0 = q[2], b1 = q[3];
              const float a = ((a0.x + a0.y) + (a0.z + a0.w)) + ((a1.x + a1.y) + (a1.z + a1.w)), b = ((b0.x + b0.y) + (b0.z + b0.w)) + ((b1.x + b1.y) + (b1.z + b1.w));
              const float ra = 1.f / sqrtf(a * (1.f / 512.f) + RMS_EPS), rb = 1.f / sqrtf(b * (1.f / 512.f) + RMS_EPS);
              tab[un * 256 + r] = (pg8::f32x2){ra / rb, rb}; } }
        LDS_WAIT(); __syncthreads();
        pg8::EpiOut E{x, X1, SSQ1, (const LAS pg8::f32x2*)tab};
        pg8::gemm_phase<pg8::EpiOut, pg8::StaticOrder, true, true, true>(F.lds + RING_OFF, g, S, E, F.wave);
        if (BOTH(3)) xcd_barrier(bar);
    }
    if (((MK_BUILD >> 4) & 1) && IN(4)) {
        pg8::Gemm g{X1, WT_GATE, MTOK, DM, DM}; pg8::StaticOrder S; S.init(MTOK, DM, F.G, (int)blockIdx.x);
        __syncthreads();
        { pg8::Unit uu; const int tid_ = F.wave * 64 + LANE_ID(); const int un = tid_ >> 8, r = tid_ & 255;
          if (S.next(un, uu)) { const GAS f32x4* q = (const GAS f32x4*)(SSQ1 + (size_t)(uu.pm * 256 + r) * 16);
              const f32x4 a0 = q[0], a1 = q[1], b0 = q[2], b1 = q[3];
              const float a = (((a0.x + a0.y) + (a0.z + a0.w)) + ((a1.x + a1.y) + (a1.z + a1.w))) + (((b0.x + b0.y) + (b0.z + b0.w)) + ((b1.x + b1.y) + (b1.z + b1.w)));
              tab[un * 256 + r] = (pg8::f32x2){1.f / sqrtf(a * (1.f / DM) + RMS_EPS), 0.f}; } }
        LDS_WAIT(); __syncthreads();
        pg8::EpiGate E{X1, PLE, out, (const LAS pg8::f32x2*)tab};
        pg8::gemm_phase<pg8::EpiGate, pg8::StaticOrder, true, true, false>(F.lds + RING_OFF, g, S, E, F.wave);
        if (BOTH(4)) xcd_barrier(bar);
    }
    if (((MK_BUILD >> 5) & 1) && IN(5)) {
        for (int m = gw; m < MTOK; m += NGW) final_norm_row(out + (size_t)m * DM, g_final, LANE_ID());
    }
#undef IN
#undef BOTH
}

#ifndef MK_BUILD
#define MK_BUILD 0x3F
#endif
#ifndef MK_MASK
#define MK_MASK 0x3B
#endif
extern "C" void kernel_launch(void* const* d_in, const int* in_sizes, int n_in, void* d_out, int out_size, void* d_ws, size_t ws_size, hipStream_t stream) {
    static int grid = 0;
    if (grid == 0) {
        if (n_in != 11 || in_sizes[0] != MTOK * DM || out_size != MTOK * DM || ws_size < WS_END) {
            fprintf(stderr, "kernel_launch: unexpected shapes n_in %d in0 %d out %d ws %zu\n", n_in, n_in > 0 ? in_sizes[0] : -1, out_size, ws_size); grid = -1; return; }
        int dev = 0, cus = 0;
        if (hipGetDevice(&dev) != hipSuccess || hipDeviceGetAttribute(&cus, hipDeviceAttributeMultiprocessorCount, dev) != hipSuccess) { grid = -1; return; }
        if (hipFuncSetAttribute((const void*)mk_fwd, hipFuncAttributeMaxDynamicSharedMemorySize, LDS_BYTES) != hipSuccess) { fprintf(stderr, "kernel_launch: hipFuncSetAttribute failed\n"); grid = -1; return; }
        int per_cu = 0;
        if (hipOccupancyMaxActiveBlocksPerMultiprocessor(&per_cu, (const void*)mk_fwd, NWAVES * 64, LDS_BYTES) != hipSuccess || per_cu < 1) { fprintf(stderr, "kernel_launch: occupancy query says %d\n", per_cu); }
        (void)hipGetLastError();
        grid = cus;
    }
    if (grid < 0) return;
    const float* x = (const float*)d_in[0]; const float* p = (const float*)d_in[1]; const float* w_in = (const float*)d_in[2];
    const float* g_mix = (const float*)d_in[3]; const float* g_sb = (const float*)d_in[4]; const float* g_mb = (const float*)d_in[5];
    const float* w_out = (const float*)d_in[6]; const float* w_ple = (const float*)d_in[7]; const float* g_ple = (const float*)d_in[8];
    const float* w_gate = (const float*)d_in[9]; const float* g_final = (const float*)d_in[10];
    unsigned char* ws = (unsigned char*)d_ws; float* out = (float*)d_out;
    bf16_t* WT_IN = (bf16_t*)(ws + WS_WT_IN); bf16_t* WT_OUT = (bf16_t*)(ws + WS_WT_OUT); bf16_t* WT_GATE = (bf16_t*)(ws + WS_WT_GATE); bf16_t* WT_PLE = (bf16_t*)(ws + WS_WT_PLE);
    float* KSUM = (float*)(ws + WS_KSUM); float* SSQ = (float*)(ws + WS_SSQ); float* SSQ1 = (float*)(ws + WS_SSQ1);
    bf16_t* XN = (bf16_t*)(ws + WS_XN); bf16_t* Y = (bf16_t*)(ws + WS_Y); bf16_t* PB = (bf16_t*)(ws + WS_PB); bf16_t* PLE = (bf16_t*)(ws + WS_PLE);
    bf16_t* X1 = (bf16_t*)(ws + WS_X1); bf16_t* PROJ = (bf16_t*)(ws + WS_PROJ);
    (void)hipMemsetAsync(ws + WS_CTL, 0, CTL_ZERO_BYTES, stream);
    Args a{};
    for (int i = 0; i < 11; ++i) a.in[i] = (const float*)d_in[i];
    a.out = out; a.ws = ws;
    int li = 0;
    for (int ph = 0; ph < 6;) {
        if ((MK_MASK >> ph) & 1) {
            int e = ph; while (e < 6 && ((MK_MASK >> e) & 1)) ++e;
            a.ph_lo = ph; a.ph_hi = e; a.li = li++;
            hipLaunchKernelGGL(mk_fwd, dim3(grid), dim3(NWAVES * 64), LDS_BYTES, stream, a);
            ph = e; continue;
        }
        EpiP ep{};
        switch (ph) {
        case 0:
            nv_transpose_w<<<(DM * NPROJ + 255) / 256, 256, 0, stream>>>(w_in, DM, NPROJ, WT_IN, nullptr);
            nv_transpose_w<<<(DM * DM + 255) / 256, 256, 0, stream>>>(w_out, DM, DM, WT_OUT, nullptr);
            nv_transpose_w<<<(DM * DM + 255) / 256, 256, 0, stream>>>(w_gate, DM, DM, WT_GATE, g_ple);
            nv_transpose_w<<<(DPLE * DM + 255) / 256, 256, 0, stream>>>(w_ple, DPLE, DM, WT_PLE, nullptr);
            nv_rmsnorm_bf16<<<MTOK / 4, 256, 0, stream>>>(x, g_mix, XN);
            nv_cvt_bf16<<<(MTOK * DPLE + 255) / 256, 256, 0, stream>>>(p, PB, (size_t)MTOK * DPLE);
            break;
        case 1:
            ep.obf = PROJ; nv_gemm<EPI_PROJ><<<dim3(NPROJ / 128, MTOK / 128), 256, 0, stream>>>(XN, WT_IN, MTOK, NPROJ, DM, ep);
            ep = EpiP{}; ep.obf = PLE; nv_gemm<EPI_PLE><<<dim3(DM / 128, MTOK / 128), 256, 0, stream>>>(PB, WT_PLE, MTOK, DM, DPLE, ep);
            nv_ksum<<<MTOK / 256, 512, 0, stream>>>(PROJ, KSUM);
            break;
        case 2:
            nv_sb<<<dim3(SEQ / 64, NB * NH), 64, 0, stream>>>(PROJ, g_sb, Y, SSQ);
            nv_moba<<<dim3(SEQ / 64, NB * NH), 64, 0, stream>>>(PROJ, KSUM, g_mb, Y, SSQ);
            break;
        case 3:
            ep.obf = X1; ep.x = x; ep.ssq = SSQ; nv_gemm<EPI_OUT><<<dim3(DM / 128, MTOK / 128), 256, 0, stream>>>(Y, WT_OUT, MTOK, DM, DM, ep);
            nv_ssq1<<<MTOK / 4, 256, 0, stream>>>(X1, SSQ1);
            break;
        case 4:
            ep.of32 = out; ep.ssq1 = SSQ1; ep.x1 = X1; ep.ple = PLE; nv_gemm<EPI_GATE><<<dim3(DM / 128, MTOK / 128), 256, 0, stream>>>(X1, WT_GATE, MTOK, DM, DM, ep);
            break;
        default:
            nv_final_norm<<<MTOK / 4, 256, 0, stream>>>(out, g_final);
            break;
        }
        ++ph;
    }
}
```

```cpp
#include <hip/hip_runtime.h>
#include <cstdio>
#include <cstdint>

typedef unsigned short bf16_t;
#ifndef MK_BUILD
#define MK_BUILD 0x3F
#endif
#ifndef P2_PARTS
#define P2_PARTS 3
#endif
constexpr int NB = 8, SEQ = 4096, MTOK = NB * SEQ, DM = 1024, NPROJ = 4096, DPLE = 256, NH = 8, HD = 64;
constexpr float RMS_EPS = 1e-6f;
constexpr float LOG2E = 1.4426950408889634f;
constexpr float C2 = 0.125f * LOG2E;

constexpr size_t MiB = 1u << 20;
constexpr size_t WS_CTL = 0, CTL_ZERO_BYTES = 1 * MiB;
constexpr size_t WS_WT_IN = 2 * MiB;
constexpr size_t WS_WT_OUT = 10 * MiB;
constexpr size_t WS_WT_GATE = 12 * MiB;
constexpr size_t WS_WT_PLE = 14 * MiB;
constexpr size_t WS_KSUM = 15 * MiB;
constexpr size_t WS_SSQ = 16 * MiB;
constexpr size_t WS_SSQ1 = 18 * MiB;
constexpr size_t WS_XN = 32 * MiB;
constexpr size_t WS_Y = 32 * MiB;
constexpr size_t WS_PB = 96 * MiB;
constexpr size_t WS_PLE = 112 * MiB;
constexpr size_t WS_X1 = 176 * MiB;
constexpr size_t WS_PROJ = 240 * MiB;
constexpr size_t WS_END = 496 * MiB;

__device__ __forceinline__ float bf2f(bf16_t v) { return __uint_as_float((unsigned)v << 16); }
__device__ __forceinline__ bf16_t f2bf(float f) { unsigned u = __float_as_uint(f); return (bf16_t)((u + 0x7fffu + ((u >> 16) & 1u)) >> 16); }

__global__ void nv_transpose_w(const float* W, int K, int N, bf16_t* WT, const float* rs) {
    size_t i = (size_t)blockIdx.x * blockDim.x + threadIdx.x;
    if (i >= (size_t)K * N) return;
    int n = (int)(i / K), k = (int)(i % K);
    float v = W[(size_t)k * N + n];
    if (rs) v *= rs[k];
    WT[i] = f2bf(v);
}
__global__ void nv_rmsnorm_bf16(const float* x, const float* g, bf16_t* xn) {
    int row = blockIdx.x * 4 + (threadIdx.x >> 6), lane = threadIdx.x & 63;
    const float* xr = x + (size_t)row * DM;
    float v[16]; float s = 0.f;
#pragma unroll
    for (int j = 0; j < 16; ++j) { v[j] = xr[lane + 64 * j]; s += v[j] * v[j]; }
#pragma unroll
    for (int o = 1; o < 64; o <<= 1) s += __shfl_xor(s, o);
    float rstd = rsqrtf(s * (1.f / DM) + RMS_EPS);
#pragma unroll
    for (int j = 0; j < 16; ++j) xn[(size_t)row * DM + lane + 64 * j] = f2bf(v[j] * rstd * g[lane + 64 * j]);
}
__global__ void nv_cvt_bf16(const float* p, bf16_t* o, size_t n) {
    size_t i = (size_t)blockIdx.x * blockDim.x + threadIdx.x;
    if (i < n) o[i] = f2bf(p[i]);
}
struct EpiP { bf16_t* obf; float* of32; const float* x; const float* ssq; const float* ssq1; const bf16_t* x1; const bf16_t* ple; int pad0, pad1; };
enum { EPI_PROJ = 0, EPI_PLE = 1, EPI_OUT = 2, EPI_GATE = 3 };
template <int MODE>
__global__ __launch_bounds__(256) void nv_gemm(const bf16_t* A, const bf16_t* Bt, int M, int N, int K, EpiP ep) {
    __shared__ float As[16][132], Bs[16][132];
    const int tid = threadIdx.x, tx = tid & 15, ty = tid >> 4;
    const int bm = blockIdx.y * 128, bn = blockIdx.x * 128;
    float acc[8][8];
#pragma unroll
    for (int i = 0; i < 8; ++i)
#pragma unroll
        for (int j = 0; j < 8; ++j) acc[i][j] = 0.f;
    const int lr = tid >> 1, lk = (tid & 1) * 8;
    float ratio[8];
    if (MODE == EPI_OUT) {
#pragma unroll
        for (int i = 0; i < 8; ++i) {
            const float* q = ep.ssq + (size_t)(bm + ty * 8 + i) * 16;
            float a = 0.f, b = 0.f;
            for (int h = 0; h < 8; ++h) { a += q[h]; b += q[8 + h]; }
            float ra = rsqrtf(a * (1.f / 512.f) + RMS_EPS), rb = rsqrtf(b * (1.f / 512.f) + RMS_EPS);
            ratio[i] = ra / rb;
        }
    }
    for (int k0 = 0; k0 < K; k0 += 16) {
        if (MODE == EPI_OUT && k0 == 512) {
#pragma unroll
            for (int i = 0; i < 8; ++i)
#pragma unroll
                for (int j = 0; j < 8; ++j) acc[i][j] *= ratio[i];
        }
        {
            const uint4 va = *(const uint4*)(A + (size_t)(bm + lr) * K + k0 + lk);
            const uint4 vb = *(const uint4*)(Bt + (size_t)(bn + lr) * K + k0 + lk);
            const unsigned ua[4] = {va.x, va.y, va.z, va.w}, ub[4] = {vb.x, vb.y, vb.z, vb.w};
#pragma unroll
            for (int i = 0; i < 4; ++i) {
                As[lk + 2 * i][lr] = __uint_as_float(ua[i] << 16); As[lk + 2 * i + 1][lr] = __uint_as_float(ua[i] & 0xffff0000u);
                Bs[lk + 2 * i][lr] = __uint_as_float(ub[i] << 16); Bs[lk + 2 * i + 1][lr] = __uint_as_float(ub[i] & 0xffff0000u);
            }
        }
        __syncthreads();
#pragma unroll
        for (int kk = 0; kk < 16; ++kk) {
            float a[8], b[8];
#pragma unroll
            for (int i = 0; i < 8; ++i) { a[i] = As[kk][ty * 8 + i]; b[i] = Bs[kk][tx * 8 + i]; }
#pragma unroll
            for (int i = 0; i < 8; ++i)
#pragma unroll
                for (int j = 0; j < 8; ++j) acc[i][j] += a[i] * b[j];
        }
        __syncthreads();
    }
#pragma unroll
    for (int i = 0; i < 8; ++i) {
        const int m = bm + ty * 8 + i;
        float rs = 1.f;
        if (MODE == EPI_OUT) {
            const float* q = ep.ssq + (size_t)m * 16; float b = 0.f;
            for (int h = 0; h < 8; ++h) b += q[8 + h];
            rs = rsqrtf(b * (1.f / 512.f) + RMS_EPS);
        }
        if (MODE == EPI_GATE) {
            const float* q = ep.ssq1 + (size_t)m * 16; float b = 0.f;
            for (int h = 0; h < 16; ++h) b += q[h];
            rs = rsqrtf(b * (1.f / DM) + RMS_EPS);
        }
#pragma unroll
        for (int j = 0; j < 8; ++j) {
            const int n = bn + tx * 8 + j; float v = acc[i][j];
            if (MODE == EPI_PROJ) {
                const int g = n >> 9;
                if (g == 0 || g == 4) v *= C2;
                else if (g == 3 || g == 7) v = v / (1.f + __expf(-v));
                ep.obf[(size_t)m * N + n] = f2bf(v);
            } else if (MODE == EPI_PLE) {
                ep.obf[(size_t)m * N + n] = f2bf(v);
            } else if (MODE == EPI_OUT) {
                ep.obf[(size_t)m * N + n] = f2bf(ep.x[(size_t)m * N + n] + rs * v);
            } else {
                const float gate = 1.f / (1.f + __expf(-rs * v));
                ep.of32[(size_t)m * N + n] = bf2f(ep.x1[(size_t)m * N + n]) + bf2f(ep.ple[(size_t)m * N + n]) * gate;
            }
        }
    }
}
__global__ void nv_ksum(const bf16_t* PROJ, float* KSUM) {
    int blk = blockIdx.x, c = threadIdx.x;
    float s = 0.f;
    for (int r = 0; r < 256; ++r) s += bf2f(PROJ[(size_t)(blk * 256 + r) * NPROJ + 2560 + c]);
    KSUM[(size_t)blk * 1024 + c] = s; KSUM[(size_t)blk * 1024 + 512 + c] = 0.f;
}
__global__ __launch_bounds__(64) void nv_sb(const bf16_t* PROJ, const float* g_sb, bf16_t* Y, float* SSQ) {
    const int bh = blockIdx.y, b = bh >> 3, h = bh & 7, lane = threadIdx.x;
    const int t = blockIdx.x * 64 + lane;
    const size_t row = (size_t)b * SEQ + t;
    float q[64], o[64];
    {
        const bf16_t* qp = PROJ + row * NPROJ + h * 64;
#pragma unroll
        for (int d = 0; d < 64; ++d) { q[d] = bf2f(qp[d]); o[d] = 0.f; }
    }
    float L = 0.f;
    const int smax = blockIdx.x * 64 + 62;
    for (int s = smax; s >= 0; --s) {
        const bf16_t* kp = PROJ + ((size_t)b * SEQ + s) * NPROJ + 512 + h * 64;
        const bf16_t* vp = kp + 512;
        float u = 0.f;
#pragma unroll
        for (int d = 0; d < 64; ++d) u += q[d] * bf2f(kp[d]);
        const float g = __log2f(1.f + exp2f(-fabsf(u)));
        const float l = fmaxf(u, 0.f) + g, ls = fminf(u, 0.f) - g;
        if (s < t) {
            const float w = exp2f(ls - L);
#pragma unroll
            for (int d = 0; d < 64; ++d) o[d] += w * bf2f(vp[d]);
            L += l;
        }
        if (s < blockIdx.x * 64 && __all(L > 200.f)) break;
    }
    float ss = 0.f;
#pragma unroll
    for (int d = 0; d < 64; ++d) ss += o[d] * o[d];
    SSQ[row * 16 + h] = ss;
    const bf16_t* zp = PROJ + row * NPROJ + 1536 + h * 64;
#pragma unroll
    for (int d = 0; d < 64; ++d) Y[row * DM + h * 64 + d] = f2bf(o[d] * bf2f(zp[d]) * g_sb[h * 64 + d]);
}
__global__ __launch_bounds__(64) void nv_moba(const bf16_t* PROJ, const float* KSUM, const float* g_mb, bf16_t* Y, float* SSQ) {
    const int bh = blockIdx.y, b = bh >> 3, h = bh & 7, lane = threadIdx.x;
    const int t = blockIdx.x * 64 + lane, blk = t >> 8;
    const size_t row = (size_t)b * SEQ + t;
    float q[64], o[64];
    {
        const bf16_t* qp = PROJ + row * NPROJ + 2048 + h * 64;
#pragma unroll
        for (int d = 0; d < 64; ++d) { q[d] = bf2f(qp[d]); o[d] = 0.f; }
    }
    float g0 = -INFINITY, g1 = -INFINITY, g2 = -INFINITY; int i0 = -1, i1 = -1, i2 = -1;
    for (int j = 0; j < blk; ++j) {
        const float* ks = KSUM + (size_t)(b * 16 + j) * 1024 + h * 64;
        float g = 0.f;
#pragma unroll
        for (int d = 0; d < 64; ++d) g += q[d] * (ks[d] + ks[512 + d]);
        if (g > g0) { g2 = g1; i2 = i1; g1 = g0; i1 = i0; g0 = g; i0 = j; }
        else if (g > g1) { g2 = g1; i2 = i1; g1 = g; i1 = j; }
        else if (g > g2) { g2 = g; i2 = j; }
    }
    const float slope2 = exp2f(-(float)(h + 1)) * LOG2E;
    float m = -INFINITY, l = 0.f;
    for (int slot = 0; slot < 4; ++slot) {
        const int kb = slot == 0 ? blk : (slot == 1 ? i0 : (slot == 2 ? i1 : i2));
        if (kb < 0) continue;
        for (int kk = 0; kk < 256; ++kk) {
            const int s = kb * 256 + kk;
            if (s > t) break;
            const bf16_t* kp = PROJ + ((size_t)b * SEQ + s) * NPROJ + 2560 + h * 64;
            const bf16_t* vp = kp + 512;
            float sc = 0.f;
#pragma unroll
            for (int d = 0; d < 64; ++d) sc += q[d] * bf2f(kp[d]);
            sc += slope2 * (float)(s - t);
            if (sc > m) {
                const float a = exp2f(m - sc);
                l *= a;
#pragma unroll
                for (int d = 0; d < 64; ++d) o[d] *= a;
                m = sc;
            }
            const float pw = exp2f(sc - m);
            l += pw;
#pragma unroll
            for (int d = 0; d < 64; ++d) o[d] += pw * bf2f(vp[d]);
        }
    }
    const float il = 1.f / l;
    float ss = 0.f;
#pragma unroll
    for (int d = 0; d < 64; ++d) { o[d] *= il; ss += o[d] * o[d]; }
    SSQ[row * 16 + 8 + h] = ss;
    const bf16_t* zp = PROJ + row * NPROJ + 3584 + h * 64;
#pragma unroll
    for (int d = 0; d < 64; ++d) Y[row * DM + 512 + h * 64 + d] = f2bf(o[d] * bf2f(zp[d]) * g_mb[h * 64 + d]);
}
__global__ void nv_ssq1(const bf16_t* X1, float* SSQ1) {
    int row = blockIdx.x * 4 + (threadIdx.x >> 6), lane = threadIdx.x & 63;
    float s = 0.f;
#pragma unroll
    for (int j = 0; j < 16; ++j) { float v = bf2f(X1[(size_t)row * DM + lane + 64 * j]); s += v * v; }
#pragma unroll
    for (int o = 1; o < 64; o <<= 1) s += __shfl_xor(s, o);
    if (lane < 16) SSQ1[(size_t)row * 16 + lane] = lane == 0 ? s : 0.f;
}
__global__ void nv_final_norm(float* out, const float* g) {
    int row = blockIdx.x * 4 + (threadIdx.x >> 6), lane = threadIdx.x & 63;
    float* xr = out + (size_t)row * DM;
    float v[16]; float s = 0.f;
#pragma unroll
    for (int j = 0; j < 16; ++j) { v[j] = xr[lane + 64 * j]; s += v[j] * v[j]; }
#pragma unroll
    for (int o = 1; o < 64; o <<= 1) s += __shfl_xor(s, o);
    float rstd = rsqrtf(s * (1.f / DM) + RMS_EPS);
#pragma unroll
    for (int j = 0; j < 16; ++j) xr[lane + 64 * j] = v[j] * rstd * g[lane + 64 * j];
}

namespace pg8 {
#define PG8_LAS __attribute__((address_space(3)))
typedef short bf16x8 __attribute__((ext_vector_type(8)));
typedef float f32x4 __attribute__((ext_vector_type(4)));
typedef float f32x2 __attribute__((ext_vector_type(2)));
typedef unsigned u32x4 __attribute__((ext_vector_type(4)));
constexpr int BM = 256, BK = 64, HALF = 128, HTB = HALF * BK * 2  , STAGE_BYTES = 8 * HTB, NXCD = 8, WGM = 8;

__host__ __device__ __forceinline__ int lds_byte(int r, int c) { const int st = (r >> 4) * 2 + (c >> 5), rr = r & 15, cc = c & 31, ob = rr * 64 + cc * 2; return st * 1024 + (ob ^ (((ob >> 9) & 1) << 5)); }
__host__ __device__ __forceinline__ void stage_rc(int b, int& R, int& C) { const int st = b / 1024, sb = b % 1024, swz = sb ^ (((sb >> 9) & 1) << 5); R = (st >> 1) * 16 + swz / 64; C = (st & 1) * 32 + (swz % 64) / 2; }
__host__ __device__ __forceinline__ int perm32(int rho) { const int n = rho >> 4, i = rho & 15; return 8 * (i >> 2) + 4 * n + (i & 3); }

struct Unit { int pm, pn; };
struct Gemm { const bf16_t* A; const bf16_t* Bt; int M, N, K; };

struct StaticOrder {
    int nM, nN, nwg, G, c;
    __host__ __device__ void init(int M, int N, int G_, int c_) { nM = M / BM; nN = N / BM; nwg = nM * nN; G = G_; c = c_; }
    __host__ __device__ bool next(int i, Unit& u) const {
        const long L = (long)i * G + c; if (L >= nwg) return false;
        int wgid = (int)L; { const int q = nwg / NXCD, r = nwg % NXCD, xcd = wgid % NXCD, off = wgid / NXCD; wgid = (xcd < r ? xcd * (q + 1) : r * (q + 1) + (xcd - r) * q) + off; }
        const int nig = WGM * nN, gid = wgid / nig, fm = gid * WGM, gsz = (nM - fm) < WGM ? (nM - fm) : WGM;
        u.pm = fm + ((wgid % nig) % gsz); u.pn = (wgid % nig) / gsz; return true;
    }
    __device__ __forceinline__ void a_ready(const Unit&) const {}
    __device__ __forceinline__ void done(const Unit&) const {}
};

__device__ __forceinline__ unsigned cvt_pk_bf16(float lo, float hi) { unsigned r; asm volatile("v_cvt_pk_bf16_f32 %0, %1, %2" : "=v"(r) : "v"(lo), "v"(hi)); return r; }
__device__ __forceinline__ u32x4 pack8(const f32x4 v0, const f32x4 v1) { u32x4 w; w.x = cvt_pk_bf16(v0[0], v0[1]); w.y = cvt_pk_bf16(v0[2], v0[3]); w.z = cvt_pk_bf16(v1[0], v1[1]); w.w = cvt_pk_bf16(v1[2], v1[3]); return w; }
__device__ __forceinline__ float silu_f(float v) { return v * __builtin_amdgcn_rcpf(1.f + __builtin_amdgcn_exp2f(-v * LOG2E)); }
__device__ __forceinline__ float sigm_f(float v) { return __builtin_amdgcn_rcpf(1.f + __builtin_amdgcn_exp2f(-v * LOG2E)); }

struct EpiStore {
    static constexpr bool PERM = true, AFTER_DRAIN = false;
    bf16_t* O; int ldc;
    __device__ __forceinline__ void midk(f32x4 (&)[2][2][4][2], int, int, int) const {}
    __device__ __forceinline__ void operator()(const f32x4 (&acc)[2][2][4][2], const Unit& u, int ui, int wr, int wc, int fr, int fq) const {
        const int row0 = u.pm * BM + wr * 64 + fr, col0 = u.pn * BM + wc * 32 + 8 * fq;
#pragma unroll
        for (int ai = 0; ai < 2; ++ai)
#pragma unroll
            for (int m = 0; m < 4; ++m) { bf16_t* rowp = O + (size_t)(row0 + ai * HALF + m * 16) * ldc + col0;
#pragma unroll
                for (int bj = 0; bj < 2; ++bj) *(u32x4*)(rowp + bj * HALF) = pack8(acc[ai][bj][m][0], acc[ai][bj][m][1]); }
    }
};
struct EpiProj {
    static constexpr bool PERM = true, AFTER_DRAIN = false;
    bf16_t* O; float* ksum;
    __device__ __forceinline__ void midk(f32x4 (&)[2][2][4][2], int, int, int) const {}
    __device__ __forceinline__ void operator()(const f32x4 (&acc)[2][2][4][2], const Unit& u, int ui, int wr, int wc, int fr, int fq) const {
        const int row0 = u.pm * BM + wr * 64 + fr, col0 = u.pn * BM + wc * 32 + 8 * fq;
        const int g = u.pn >> 1;
        const bool isq = (g == 0) || (g == 4), isz = (g == 3) || (g == 7);
        const float sc = isq ? C2 : 1.f;
#pragma unroll
        for (int ai = 0; ai < 2; ++ai)
#pragma unroll
            for (int m = 0; m < 4; ++m) { bf16_t* rowp = O + (size_t)(row0 + ai * HALF + m * 16) * NPROJ + col0;
#pragma unroll
                for (int bj = 0; bj < 2; ++bj) { f32x4 v0 = acc[ai][bj][m][0] * sc, v1 = acc[ai][bj][m][1] * sc;
                    if (isz) {
#pragma unroll
                        for (int j = 0; j < 4; ++j) { v0[j] = silu_f(v0[j]); v1[j] = silu_f(v1[j]); } }
                    *(u32x4*)(rowp + bj * HALF) = pack8(v0, v1); } }
        if (g == 5) {
            float* kp = ksum + (size_t)(u.pm * 2 + wr) * 512 + (u.pn * BM - 2560) + wc * 32 + 8 * fq;
#pragma unroll
            for (int bj = 0; bj < 2; ++bj)
#pragma unroll
                for (int n = 0; n < 2; ++n) { f32x4 s = (f32x4){0.f, 0.f, 0.f, 0.f};
#pragma unroll
                    for (int ai = 0; ai < 2; ++ai)
#pragma unroll
                        for (int m = 0; m < 4; ++m) s += acc[ai][bj][m][n];
#pragma unroll
                    for (int j = 0; j < 4; ++j) { float v = s[j]; v += __shfl_xor(v, 1); v += __shfl_xor(v, 2); v += __shfl_xor(v, 4); v += __shfl_xor(v, 8); s[j] = v; }
                    if (fr == 0) *(f32x4*)(kp + bj * HALF + 4 * n) = s; }
        }
    }
};
struct EpiOut {
    static constexpr bool PERM = true, AFTER_DRAIN = false;
    const float* x; bf16_t* X1; float* ssq1; const PG8_LAS f32x2* tab;
    __device__ __forceinline__ void midk(f32x4 (&acc)[2][2][4][2], int ui, int wr, int fr) const {
#pragma unroll
        for (int ai = 0; ai < 2; ++ai)
#pragma unroll
            for (int m = 0; m < 4; ++m) { const float f = tab[ui * 256 + ai * HALF + wr * 64 + m * 16 + fr].x;
#pragma unroll
                for (int bj = 0; bj < 2; ++bj)
#pragma unroll
                    for (int n = 0; n < 2; ++n) acc[ai][bj][m][n] *= f; }
    }
    __device__ __forceinline__ void operator()(const f32x4 (&acc)[2][2][4][2], const Unit& u, int ui, int wr, int wc, int fr, int fq) const {
        const int col0 = u.pn * BM + wc * 32 + 8 * fq;
#pragma unroll
        for (int ai = 0; ai < 2; ++ai)
#pragma unroll
            for (int m = 0; m < 4; ++m) { const int r = ai * HALF + wr * 64 + m * 16 + fr; const float rs = tab[ui * 256 + r].y;
                const size_t off = (size_t)(u.pm * BM + r) * DM + col0; float ss = 0.f;
#pragma unroll
                for (int bj = 0; bj < 2; ++bj) { const f32x4 a0 = *(const f32x4*)(x + off + bj * HALF), a1 = *(const f32x4*)(x + off + bj * HALF + 4);
                    const f32x4 v0 = a0 + acc[ai][bj][m][0] * rs, v1 = a1 + acc[ai][bj][m][1] * rs;
                    ss += (v0[0] * v0[0] + v0[1] * v0[1]) + (v0[2] * v0[2] + v0[3] * v0[3]) + (v1[0] * v1[0] + v1[1] * v1[1]) + (v1[2] * v1[2] + v1[3] * v1[3]);
                    *(u32x4*)(X1 + off + bj * HALF) = pack8(v0, v1); }
                ss += __shfl_xor(ss, 16); ss += __shfl_xor(ss, 32);
                if (fq == 0) ssq1[(size_t)(u.pm * BM + r) * 16 + u.pn * 4 + wc] = ss;
                if (m & 1) asm volatile("" ::: "memory"); }
    }
};
struct EpiGate {
    static constexpr bool PERM = true, AFTER_DRAIN = false;
    const bf16_t* X1; const bf16_t* PLE; float* out; const PG8_LAS f32x2* tab;
    __device__ __forceinline__ void midk(f32x4 (&)[2][2][4][2], int, int, int) const {}
    __device__ __forceinline__ void operator()(const f32x4 (&acc)[2][2][4][2], const Unit& u, int ui, int wr, int wc, int fr, int fq) const {
        const int col0 = u.pn * BM + wc * 32 + 8 * fq;
#pragma unroll
        for (int ai = 0; ai < 2; ++ai)
#pragma unroll
            for (int m = 0; m < 4; ++m) { const int r = ai * HALF + wr * 64 + m * 16 + fr; const float rs = tab[ui * 256 + r].x;
                const size_t off = (size_t)(u.pm * BM + r) * DM + col0;
#pragma unroll
                for (int bj = 0; bj < 2; ++bj) { const u32x4 xa = *(const u32x4*)(X1 + off + bj * HALF), pa = *(const u32x4*)(PLE + off + bj * HALF);
                    f32x4 o0, o1;
#pragma unroll
                    for (int j = 0; j < 2; ++j) {
                        o0[2 * j]     = __uint_as_float(xa[j] << 16)             + __uint_as_float(pa[j] << 16)             * sigm_f(rs * acc[ai][bj][m][0][2 * j]);
                        o0[2 * j + 1] = __uint_as_float(xa[j] & 0xffff0000u)     + __uint_as_float(pa[j] & 0xffff0000u)     * sigm_f(rs * acc[ai][bj][m][0][2 * j + 1]);
                        o1[2 * j]     = __uint_as_float(xa[2 + j] << 16)         + __uint_as_float(pa[2 + j] << 16)         * sigm_f(rs * acc[ai][bj][m][1][2 * j]);
                        o1[2 * j + 1] = __uint_as_float(xa[2 + j] & 0xffff0000u) + __uint_as_float(pa[2 + j] & 0xffff0000u) * sigm_f(rs * acc[ai][bj][m][1][2 * j + 1]); }
                    *(f32x4*)(out + off + bj * HALF) = o0; *(f32x4*)(out + off + bj * HALF + 4) = o1; }
                if (m & 1) asm volatile("" ::: "memory"); }
    }
};

template <class Epi, class Sched, bool ALIGN_EPI = false, bool SP2 = false, bool MIDK = false>
__device__ __forceinline__ void gemm_phase(PG8_LAS unsigned char* lds, const Gemm g, const Sched& S, const Epi& E, const int wid) {
    const int lane = (int)__builtin_amdgcn_mbcnt_hi(~0u, __builtin_amdgcn_mbcnt_lo(~0u, 0u)), tid = wid * 64 + lane, wr = wid >> 2, wc = wid & 3, fr = lane & 15, fq = lane >> 4;
    const int K = g.K, nt = K / BK;
    unsigned voffA[2], voffB[2];
#pragma unroll
    for (int i = 0; i < 2; ++i) { int R, C; stage_rc(tid * 16 + i * 8192, R, C); const int Rb = Epi::PERM ? ((R & ~31) + perm32(R & 31)) : R;
        voffA[i] = (unsigned)(R * K + C) * 2u; voffB[i] = (unsigned)(Rb * K + C) * 2u; }
    const size_t kstep = (size_t)(BK * 2);
    const size_t hstep = (size_t)HALF * K * 2;
    const size_t tstep = 2 * hstep;
    const unsigned ldsw = (unsigned)wid * 1024u;
    const int aoff = lds_byte(wr * 64 + fr, fq * 8), boff = lds_byte(wc * 32 + fr, fq * 8);
#define PG8_SA(b, h) (((b) * 2 + (h)) * HTB)
#define PG8_SB(b, h) ((4 + (b) * 2 + (h)) * HTB)
#define PG8_STAGE(bufoff, gbase, voff) do { _Pragma("unroll") for (int _i = 0; _i < 2; ++_i) \
        __builtin_amdgcn_global_load_lds((const unsigned*)((const char*)(gbase) + (voff)[_i]), (PG8_LAS unsigned*)(lds + (bufoff) + ldsw + _i * 8192), 16, 0, 0); } while (0)
#define PG8_LDA(dst, b, h) do { _Pragma("unroll") for (int m = 0; m < 4; ++m) _Pragma("unroll") for (int k = 0; k < 2; ++k) dst[m][k] = *(const PG8_LAS bf16x8*)(lds + PG8_SA(b, h) + aoff + m * 2048 + k * 1024); } while (0)
#define PG8_LDB(dst, b, h) do { _Pragma("unroll") for (int n = 0; n < 2; ++n) _Pragma("unroll") for (int k = 0; k < 2; ++k) dst[n][k] = *(const PG8_LAS bf16x8*)(lds + PG8_SB(b, h) + boff + n * 2048 + k * 1024); } while (0)
#define PG8_MMA(ai, bj, At, Bt) do { __builtin_amdgcn_s_setprio(1); _Pragma("unroll") for (int m = 0; m < 4; ++m) _Pragma("unroll") for (int n = 0; n < 2; ++n) _Pragma("unroll") for (int k = 0; k < 2; ++k) \
        acc[ai][bj][m][n] = __builtin_amdgcn_mfma_f32_16x16x32_bf16(Bt[n][k], At[m][k], acc[ai][bj][m][n], 0, 0, 0); __builtin_amdgcn_s_setprio(0); } while (0)
#define PG8_WAIT_V(n) asm volatile("s_waitcnt vmcnt(" #n ")" ::: "memory")
#define PG8_WAIT_L(n) asm volatile("s_waitcnt lgkmcnt(" #n ")" ::: "memory")
#define PG8_BAR __builtin_amdgcn_s_barrier()
#define PG8_SCHED __builtin_amdgcn_sched_barrier(0)
    Unit cur, nxt; int ui = 0;
    if (!S.next(0, cur)) return;
    f32x4 acc[2][2][4][2];
#pragma unroll
    for (int a = 0; a < 2; ++a)
#pragma unroll
        for (int b = 0; b < 2; ++b)
#pragma unroll
            for (int m = 0; m < 4; ++m)
#pragma unroll
                for (int n = 0; n < 2; ++n) acc[a][b][m][n] = (f32x4){0.f, 0.f, 0.f, 0.f};
    bf16x8 At[4][2], B0[2][2], B1[2][2];
    const char* cA = (const char*)g.A + (size_t)cur.pm * tstep; const char* cB = (const char*)g.Bt + (size_t)cur.pn * tstep;
    S.a_ready(cur);
    if constexpr (SP2) {
        PG8_STAGE(PG8_SB(0, 0), cB, voffB); PG8_STAGE(PG8_SB(0, 1), cB + hstep, voffB); PG8_STAGE(PG8_SA(0, 0), cA, voffA); PG8_STAGE(PG8_SA(0, 1), cA + hstep, voffA);
        if (wr == 1) PG8_BAR;
        PG8_WAIT_V(2); PG8_BAR;
        PG8_STAGE(PG8_SB(1, 0), cB + kstep, voffB); PG8_STAGE(PG8_SA(1, 0), cA + kstep, voffA); PG8_STAGE(PG8_SB(1, 1), cB + hstep + kstep, voffB);
        PG8_WAIT_V(6); PG8_BAR;
    } else {
        PG8_STAGE(PG8_SB(0, 0), cB, voffB); PG8_STAGE(PG8_SA(0, 0), cA, voffA); PG8_STAGE(PG8_SB(0, 1), cB + hstep, voffB); PG8_STAGE(PG8_SA(0, 1), cA + hstep, voffA);
        if (wr == 1) PG8_BAR;
        PG8_WAIT_V(4); PG8_BAR;
        PG8_STAGE(PG8_SB(1, 0), cB + kstep, voffB); PG8_STAGE(PG8_SA(1, 0), cA + kstep, voffA); PG8_STAGE(PG8_SB(1, 1), cB + hstep + kstep, voffB);
        PG8_WAIT_V(6); PG8_BAR;
    }
    for (;;) {
        const bool has_next = S.next(ui + 1, nxt);
        const char* nA = has_next ? (const char*)g.A + (size_t)nxt.pm * tstep : cA; const char* nB = has_next ? (const char*)g.Bt + (size_t)nxt.pn * tstep : cB;
        for (int t = 0; t < nt; t += 2) {
            const bool last = (t == nt - 2);
            if constexpr (MIDK) { if (t == (nt >> 1)) E.midk(acc, ui, wr, fr); }
            const char* a1 = cA + (size_t)(t + 1) * kstep;
            const char* a2 = last ? nA : cA + (size_t)(t + 2) * kstep; const char* b2 = last ? nB : cB + (size_t)(t + 2) * kstep;
            const char* a3 = a2 + kstep; const char* b3 = b2 + kstep;
            if (last && has_next) S.a_ready(nxt);
            if constexpr (SP2) {
            PG8_LDB(B0, 0, 0); PG8_LDB(B1, 0, 1); PG8_SCHED; PG8_LDA(At, 0, 0); PG8_STAGE(PG8_SA(1, 1), a1 + hstep, voffA);
            PG8_WAIT_V(8); PG8_WAIT_L(0); PG8_BAR; PG8_MMA(0, 0, At, B0); PG8_MMA(0, 1, At, B1); PG8_BAR; PG8_SCHED;
            PG8_LDA(At, 0, 1); PG8_STAGE(PG8_SB(0, 0), b2, voffB); PG8_STAGE(PG8_SB(0, 1), b2 + hstep, voffB); PG8_STAGE(PG8_SA(0, 0), a2, voffA);
            PG8_WAIT_V(8); PG8_WAIT_L(0); PG8_BAR; PG8_MMA(1, 0, At, B0); PG8_MMA(1, 1, At, B1); PG8_BAR; PG8_SCHED;
            PG8_LDB(B0, 1, 0); PG8_LDB(B1, 1, 1); PG8_SCHED; PG8_LDA(At, 1, 0); PG8_STAGE(PG8_SA(0, 1), a2 + hstep, voffA);
            PG8_WAIT_V(8); PG8_WAIT_L(0); PG8_BAR; PG8_MMA(0, 0, At, B0); PG8_MMA(0, 1, At, B1); PG8_BAR; PG8_SCHED;
            PG8_LDA(At, 1, 1); PG8_STAGE(PG8_SB(1, 0), b3, voffB); PG8_STAGE(PG8_SB(1, 1), b3 + hstep, voffB); PG8_STAGE(PG8_SA(1, 0), a3, voffA);
            PG8_WAIT_V(8); PG8_WAIT_L(0); PG8_BAR; PG8_MMA(1, 0, At, B0); PG8_MMA(1, 1, At, B1); PG8_BAR; PG8_SCHED;
            } else {
            PG8_LDB(B0, 0, 0); PG8_SCHED; PG8_LDA(At, 0, 0); PG8_STAGE(PG8_SA(1, 1), a1 + hstep, voffA);
            PG8_WAIT_L(8); PG8_BAR; PG8_WAIT_L(0); PG8_MMA(0, 0, At, B0); PG8_BAR; PG8_SCHED;
            PG8_LDB(B1, 0, 1); PG8_STAGE(PG8_SB(0, 0), b2, voffB);
            PG8_BAR; PG8_WAIT_L(0); PG8_MMA(0, 1, At, B1); PG8_BAR;
            PG8_LDA(At, 0, 1); PG8_STAGE(PG8_SA(0, 0), a2, voffA);
            PG8_BAR; PG8_WAIT_L(0); PG8_MMA(1, 0, At, B0); PG8_BAR; PG8_SCHED;
            PG8_STAGE(PG8_SB(0, 1), b2 + hstep, voffB);
            PG8_WAIT_V(6); PG8_BAR; PG8_MMA(1, 1, At, B1); PG8_BAR;
            PG8_LDB(B0, 1, 0); PG8_SCHED; PG8_LDA(At, 1, 0); PG8_STAGE(PG8_SA(0, 1), a2 + hstep, voffA);
            PG8_WAIT_L(8); PG8_BAR; PG8_WAIT_L(0); PG8_MMA(0, 0, At, B0); PG8_BAR; PG8_SCHED;
            PG8_LDB(B1, 1, 1); PG8_STAGE(PG8_SB(1, 0), b3, voffB);
            PG8_BAR; PG8_WAIT_L(0); PG8_MMA(0, 1, At, B1); PG8_BAR;
            PG8_LDA(At, 1, 1); PG8_STAGE(PG8_SA(1, 0), a3, voffA);
            PG8_BAR; PG8_WAIT_L(0); PG8_MMA(1, 0, At, B0); PG8_BAR; PG8_SCHED;
            PG8_STAGE(PG8_SB(1, 1), b3 + hstep, voffB);
            PG8_WAIT_V(6); PG8_BAR; PG8_MMA(1, 1, At, B1); PG8_BAR;
            }
        }
        if constexpr (ALIGN_EPI) { if (wr == 0) PG8_BAR; }
        if constexpr (!Epi::AFTER_DRAIN) { E(acc, cur, ui, wr, wc, fr, fq); S.done(cur); }
        if (!has_next) break;
#pragma unroll
        for (int a = 0; a < 2; ++a)
#pragma unroll
            for (int b = 0; b < 2; ++b)
#pragma unroll
                for (int m = 0; m < 4; ++m)
#pragma unroll
                    for (int n = 0; n < 2; ++n) acc[a][b][m][n] = (f32x4){0.f, 0.f, 0.f, 0.f};
        cur = nxt; cA = nA; cB = nB; ++ui;
        if constexpr (ALIGN_EPI) { if (wr == 1) PG8_BAR; }
    }
    PG8_WAIT_V(0);
    if constexpr (!ALIGN_EPI) { if (wr == 0) PG8_BAR; }
    PG8_BAR;
    if constexpr (Epi::AFTER_DRAIN) { E.fused(acc, cur, ui, wr, wc, fr, fq, lds, wid, lane); S.done(cur); }
#undef PG8_SA
#undef PG8_SB
#undef PG8_STAGE
#undef PG8_LDA
#undef PG8_LDB
#undef PG8_MMA
#undef PG8_WAIT_V
#undef PG8_WAIT_L
#undef PG8_BAR
#undef PG8_SCHED
}}

namespace att {
using bf16x8 = __attribute__((ext_vector_type(8))) short;
using s16x4 = __attribute__((ext_vector_type(4))) short;
using f32x16 = __attribute__((ext_vector_type(16))) float;
using u32x4 = __attribute__((ext_vector_type(4))) unsigned;
typedef float f32x4a __attribute__((ext_vector_type(4)));
constexpr int PITCH = NPROJ, KVBLK = 64, NW = 8;
constexpr int NSLOT = 3, SLOTB = 8192;
constexpr int LDS_K = 0, LDS_V = NSLOT * SLOTB, LDS_WS = 2 * NSLOT * SLOTB, LDS_FLG = LDS_WS + NW * 64 * 4, LDS_OST = LDS_FLG + 256, OST_W = 8704, LDS_BYTES = LDS_OST + NW * OST_W;
__device__ __forceinline__ int crow(int r, int hi) { return (r & 3) + 8 * (r >> 2) + 4 * hi; }
#define SBAR() __builtin_amdgcn_sched_barrier(0)
#define MFMA32(a, b, c) __builtin_amdgcn_mfma_f32_32x32x16_bf16(a, b, c, 0, 0, 0)
__device__ __forceinline__ void glds16(const void* gsrc, unsigned lds_dst) { unsigned keep;
    asm volatile("s_mov_b32 %0, m0\n\ts_mov_b32 m0, %2\n\ts_nop 0\n\tglobal_load_lds_dwordx4 %1, off\n\ts_mov_b32 m0, %0" : "=&s"(keep) : "v"(gsrc), "s"(lds_dst) : "memory"); }
typedef float f32x2_t __attribute__((ext_vector_type(2))); typedef __bf16 bf16x2_t __attribute__((ext_vector_type(2)));
__device__ __forceinline__ unsigned cvtpk_s(float lo, float hi) { f32x2_t v = {lo, hi}; bf16x2_t b = __builtin_convertvector(v, bf16x2_t); return __builtin_bit_cast(unsigned, b); }
#define WAIT_BAR(N) asm volatile("s_waitcnt vmcnt(" #N ") lgkmcnt(0)\n\ts_barrier" ::: "memory")
typedef __attribute__((address_space(3))) const char* lds_cptr;
typedef __attribute__((address_space(3))) char* lds_ptr;
typedef short v4i16_t __attribute__((ext_vector_type(4)));
__device__ __forceinline__ void kload8(bf16x8* kf, lds_cptr kp) {
    kf[0] = *(const __attribute__((address_space(3))) bf16x8*)(kp);        kf[1] = *(const __attribute__((address_space(3))) bf16x8*)(kp + 512);
    kf[2] = *(const __attribute__((address_space(3))) bf16x8*)(kp + 2048); kf[3] = *(const __attribute__((address_space(3))) bf16x8*)(kp + 2560);
    kf[4] = *(const __attribute__((address_space(3))) bf16x8*)(kp + 4096); kf[5] = *(const __attribute__((address_space(3))) bf16x8*)(kp + 4608);
    kf[6] = *(const __attribute__((address_space(3))) bf16x8*)(kp + 6144); kf[7] = *(const __attribute__((address_space(3))) bf16x8*)(kp + 6656);
}
__device__ __forceinline__ void kload2(bf16x8* kf, lds_cptr kp, int j) { kf[2 * j] = *(const __attribute__((address_space(3))) bf16x8*)(kp + j * 2048); kf[2 * j + 1] = *(const __attribute__((address_space(3))) bf16x8*)(kp + j * 2048 + 512); }
__device__ __forceinline__ s16x4 vtr(lds_cptr p) { return __builtin_bit_cast(s16x4, __builtin_amdgcn_ds_read_tr16_b64_v4i16((__attribute__((address_space(3))) v4i16_t*)p)); }
__device__ __forceinline__ void pv(f32x16* o, lds_cptr vp, bf16x8 pa0, bf16x8 pa1, bf16x8 pa2, bf16x8 pa3) {
#pragma unroll
    for (int d0 = 0; d0 < 2; ++d0) { s16x4 lo[4], hi[4];
#pragma unroll
        for (int ks = 0; ks < 4; ++ks) { lo[ks] = vtr(vp + d0 * 4096 + ks * 1024); hi[ks] = vtr(vp + d0 * 4096 + ks * 1024 + 512); }
#define PK(k) (bf16x8){lo[k][0], lo[k][1], lo[k][2], lo[k][3], hi[k][0], hi[k][1], hi[k][2], hi[k][3]}
        o[d0] = MFMA32(pa0, PK(0), o[d0]); o[d0] = MFMA32(pa1, PK(1), o[d0]); o[d0] = MFMA32(pa2, PK(2), o[d0]); o[d0] = MFMA32(pa3, PK(3), o[d0]);
#undef PK
    }
}
__device__ __forceinline__ void attn_epilogue(const f32x16* o, char* shm, int wid, int lane, const bf16_t* zsrc, const float* gcol, bf16_t* ydst, float* ssqdst) {
    asm volatile("" : "+v"(lane));
    const int r32 = lane & 31, hi = lane >> 5;
    __attribute__((address_space(3))) float* stg = (__attribute__((address_space(3))) float*)((lds_ptr)shm + LDS_OST + wid * OST_W);
#pragma unroll
    for (int r = 0; r < 16; ++r) { const int orow = crow(r, hi);
#pragma unroll
        for (int d0 = 0; d0 < 2; ++d0) stg[orow * 68 + d0 * 32 + r32] = o[d0][r]; }
    asm volatile("s_waitcnt lgkmcnt(0)" ::: "memory");
    const int ch = lane & 7;
    const f32x4a g0 = *(const f32x4a*)(gcol + ch * 8), g1 = *(const f32x4a*)(gcol + ch * 8 + 4);
#pragma unroll
    for (int i = 0; i < 4; ++i) { const int row = i * 8 + (lane >> 3);
        const f32x4a a0 = *(const __attribute__((address_space(3))) f32x4a*)(stg + row * 68 + ch * 8), a1 = *(const __attribute__((address_space(3))) f32x4a*)(stg + row * 68 + ch * 8 + 4);
        float ss = (a0[0] * a0[0] + a0[1] * a0[1]) + (a0[2] * a0[2] + a0[3] * a0[3]) + (a1[0] * a1[0] + a1[1] * a1[1]) + (a1[2] * a1[2] + a1[3] * a1[3]);
        ss += __shfl_xor(ss, 1); ss += __shfl_xor(ss, 2); ss += __shfl_xor(ss, 4);
        if (ch == 0) ssqdst[(size_t)row * 16] = ss;
        const u32x4 z = *(const u32x4*)(zsrc + (size_t)row * PITCH + ch * 8);
        u32x4 w;
        w[0] = cvtpk_s(a0[0] * __uint_as_float(z[0] << 16) * g0[0], a0[1] * __uint_as_float(z[0] & 0xffff0000u) * g0[1]);
        w[1] = cvtpk_s(a0[2] * __uint_as_float(z[1] << 16) * g0[2], a0[3] * __uint_as_float(z[1] & 0xffff0000u) * g0[3]);
        w[2] = cvtpk_s(a1[0] * __uint_as_float(z[2] << 16) * g1[0], a1[1] * __uint_as_float(z[2] & 0xffff0000u) * g1[1]);
        w[3] = cvtpk_s(a1[2] * __uint_as_float(z[3] << 16) * g1[2], a1[3] * __uint_as_float(z[3] & 0xffff0000u) * g1[3]);
        *(u32x4*)(ydst + (size_t)row * DM + ch * 8) = w; }
}

constexpr float SB_EXIT = 150.f;
__device__ __forceinline__ void sb_unit(int b, int h, int qb, const bf16_t* PROJ, const float* g_sb, bf16_t* Y, float* SSQ, char* shm, int wid) {
    int lane = (int)__builtin_amdgcn_mbcnt_hi(~0u, __builtin_amdgcn_mbcnt_lo(~0u, 0u)); asm volatile("" : "+v"(lane));
    const int r32 = lane & 31, hi = lane >> 5;
    const long rowbase = (long)b * SEQ; const int q0 = qb * 256;
    const bf16_t* Qw = PROJ + (rowbase + q0 + wid * 32) * PITCH + 0 + h * 64;
    const bf16_t* Kh = PROJ + rowbase * PITCH + 512 + h * 64, *Vh = PROJ + rowbase * PITCH + 1024 + h * 64;
    const unsigned lds0 = (unsigned)(uintptr_t)shm;
    volatile __attribute__((address_space(3))) unsigned* flags = (volatile __attribute__((address_space(3))) unsigned*)((lds_ptr)shm + LDS_FLG);
    const bf16_t* ksrc = Kh + (long)lane * PITCH + wid * 8;
    const bf16_t* vsrc = Vh + (long)(16 * (wid & 3) + (lane >> 2)) * PITCH + (wid >> 2) * 32 + (lane & 3) * 8;
    const unsigned kdst = lds0 + LDS_K + wid * 1024, vdst = lds0 + LDS_V + wid * 1024;
    const int Thi = qb * 4 + 3, Tw = qb * 4 + (wid >> 1);
#define SB_DMA_K(T, slot) glds16(ksrc + (long)(T) * KVBLK * PITCH, (unsigned)__builtin_amdgcn_readfirstlane(kdst + (slot)))
#define SB_DMA_V(T, slot) glds16(vsrc + (long)(T) * KVBLK * PITCH, (unsigned)__builtin_amdgcn_readfirstlane(vdst + (slot)))
    const lds_cptr shm3 = (lds_cptr)shm; const lds_cptr kp0 = shm3 + LDS_K + hi * 1024 + r32 * 16; const lds_cptr vp0 = shm3 + LDS_V + ((lane >> 4) & 1) * 32 + (lane & 3) * 8 + (4 * hi + ((lane & 15) >> 2)) * 64;
    if (wid == 0 && lane == 0) { flags[0] = 0u; flags[1] = 0u; flags[2] = 0u; }
    SB_DMA_K(Thi, 0); SB_DMA_V(Thi, 0);
    bf16x8 qr[4];
#pragma unroll
    for (int d0 = 0; d0 < 4; ++d0) qr[d0] = *reinterpret_cast<const bf16x8*>(&Qw[(long)r32 * PITCH + d0 * 16 + hi * 8]);
    bf16x8 tri[2];
#pragma unroll
    for (int s = 0; s < 2; ++s)
#pragma unroll
        for (int j = 0; j < 8; ++j) { const int kv = 16 * s + 8 * (j >> 2) + 4 * hi + (j & 3); tri[s][j] = (kv >= r32) ? (short)0x3F80 : (short)0; }
    const bf16x8 ones = (bf16x8){(short)0x3F80, (short)0x3F80, (short)0x3F80, (short)0x3F80, (short)0x3F80, (short)0x3F80, (short)0x3F80, (short)0x3F80};
    f32x16 o[2]; o[0] = f32x16{}; o[1] = f32x16{};
    float R = 0.f; bool done = false;
    int slot = 0;
    for (int s = 0; s <= Thi; ++s) {
        const int T = Thi - s; const int slot_next = (slot == (NSLOT - 1) * SLOTB) ? 0 : slot + SLOTB;
        if (T > 0) { SB_DMA_K(T - 1, slot_next); SB_DMA_V(T - 1, slot_next); WAIT_BAR(2); } else { WAIT_BAR(0); }
        if (s > 0) { const int fs = (s - 1) % 3; if (flags[fs] == 0u) break; }
        if (wid == 0 && lane == 0) flags[(s + 1) % 3] = 0u;
        if (T <= Tw && !done) {
            bf16x8 kf[8]; kload8(kf, kp0 + slot);
            const f32x16 zero = f32x16{};
            f32x16 c0 = MFMA32(kf[0], qr[0], zero), c1 = MFMA32(kf[1], qr[0], zero);
            c0 = MFMA32(kf[2], qr[1], c0); c1 = MFMA32(kf[3], qr[1], c1); c0 = MFMA32(kf[4], qr[2], c0); c1 = MFMA32(kf[5], qr[2], c1); c0 = MFMA32(kf[6], qr[3], c0); c1 = MFMA32(kf[7], qr[3], c1);
            const bool diag = (T == Tw); int rowrel = 32 * (wid & 1) + r32; asm volatile("" : "+v"(rowrel));
            f32x16 l0, l1;
#pragma unroll
            for (int r = 0; r < 16; ++r) {
                const float u0 = c0[r], u1 = c1[r];
                float a0 = fmaxf(u0, 0.f) + __builtin_amdgcn_logf(1.f + __builtin_amdgcn_exp2f(-fabsf(u0)));
                float a1 = fmaxf(u1, 0.f) + __builtin_amdgcn_logf(1.f + __builtin_amdgcn_exp2f(-fabsf(u1)));
                if (diag) { const int kv = crow(r, hi); if (kv >= rowrel) a0 = 0.f; if (kv + 32 >= rowrel) a1 = 0.f; }
                l0[r] = a0; l1[r] = a1; }
            u32x4 x00, x01, x10, x11;
#pragma unroll
            for (int j = 0; j < 4; ++j) { x00[j] = cvtpk_s(l0[2 * j], l0[2 * j + 1]); x01[j] = cvtpk_s(l0[8 + 2 * j], l0[8 + 2 * j + 1]); x10[j] = cvtpk_s(l1[2 * j], l1[2 * j + 1]); x11[j] = cvtpk_s(l1[8 + 2 * j], l1[8 + 2 * j + 1]); }
            f32x16 rt;
#pragma unroll
            for (int r = 0; r < 16; ++r) rt[r] = R;
            f32x16 y0 = MFMA32(tri[0], __builtin_bit_cast(bf16x8, x00), rt); y0 = MFMA32(tri[1], __builtin_bit_cast(bf16x8, x01), y0);
            y0 = MFMA32(ones, __builtin_bit_cast(bf16x8, x10), y0); y0 = MFMA32(ones, __builtin_bit_cast(bf16x8, x11), y0);
            f32x16 y1 = MFMA32(tri[0], __builtin_bit_cast(bf16x8, x10), rt); y1 = MFMA32(tri[1], __builtin_bit_cast(bf16x8, x11), y1);
#pragma unroll
            for (int r = 0; r < 16; ++r) {
                float w0 = __builtin_amdgcn_exp2f(c0[r] - y0[r]), w1 = __builtin_amdgcn_exp2f(c1[r] - y1[r]);
                if (diag) { const int kv = crow(r, hi); if (kv >= rowrel) w0 = 0.f; if (kv + 32 >= rowrel) w1 = 0.f; }
                c0[r] = w0; c1[r] = w1; }
            R = __shfl(y0[0], r32);
            u32x4 pw0, pw1, pw2, pw3;
#pragma unroll
            for (int j = 0; j < 4; ++j) { pw0[j] = cvtpk_s(c0[2 * j], c0[2 * j + 1]); pw1[j] = cvtpk_s(c0[8 + 2 * j], c0[8 + 2 * j + 1]); pw2[j] = cvtpk_s(c1[2 * j], c1[2 * j + 1]); pw3[j] = cvtpk_s(c1[8 + 2 * j], c1[8 + 2 * j + 1]); }
            pv(o, vp0 + slot, __builtin_bit_cast(bf16x8, pw0), __builtin_bit_cast(bf16x8, pw1), __builtin_bit_cast(bf16x8, pw2), __builtin_bit_cast(bf16x8, pw3));
            done = __all(R > SB_EXIT);
        }
        if (T > 0 && !done) flags[s % 3] = 1u;
        slot = slot_next;
    }
    asm volatile("s_waitcnt vmcnt(0)" ::: "memory");
    attn_epilogue(o, shm, wid, lane, PROJ + (rowbase + q0 + wid * 32) * PITCH + 1536 + h * 64, g_sb + h * 64, Y + (rowbase + q0 + wid * 32) * DM + h * 64, SSQ + (rowbase + q0 + wid * 32) * 16 + h);
    asm volatile("s_waitcnt vmcnt(0) lgkmcnt(0)\n\ts_barrier" ::: "memory");
#undef SB_DMA_K
#undef SB_DMA_V
}

__device__ __forceinline__ float max3f(float a, float b, float c) { float r; asm("v_max3_f32 %0, %1, %2, %3" : "=v"(r) : "v"(a), "v"(b), "v"(c)); return r; }
__device__ __forceinline__ float max2f(float a, float b) { float r; asm("v_max_f32_e32 %0, %1, %2" : "=v"(r) : "v"(a), "v"(b)); return r; }
__device__ __forceinline__ float rowmax(const f32x16& p0, const f32x16& p1) {
    float a = max3f(p0[0], p0[1], p1[0]), b = max3f(p0[2], p0[3], p1[1]); a = max3f(a, p1[2], p1[3]);
#pragma unroll
    for (int r = 4; r < 16; r += 4) { a = max3f(a, p0[r], p0[r + 1]); b = max3f(b, p0[r + 2], p0[r + 3]); a = max3f(a, p1[r], p1[r + 1]); b = max3f(b, p1[r + 2], p1[r + 3]); }
    const float m = max2f(a, b);
    auto rr = __builtin_amdgcn_permlane32_swap(__float_as_uint(m), __float_as_uint(m), false, false);
    return max2f(__uint_as_float(rr[0]), __uint_as_float(rr[1]));
}
__device__ __forceinline__ void cmask(f32x16& p0, f32x16& p1, int jb, int qrel, int hi) {
    const float NEG = -INFINITY; const int kb = 64 * jb + 4 * hi;
#pragma unroll
    for (int r = 0; r < 16; ++r) { const int kv = kb + (r & 3) + 8 * (r >> 2); if (kv > qrel) p0[r] = NEG; if (kv + 32 > qrel) p1[r] = NEG; }
}
template <int THRL> __device__ __forceinline__ void moba_unit(int b, int h, int qb, const bf16_t* PROJ, const float* KSUM, const float* g_mb, bf16_t* Y, float* SSQ, char* shm, int wid) {
    int lane = (int)__builtin_amdgcn_mbcnt_hi(~0u, __builtin_amdgcn_mbcnt_lo(~0u, 0u)); asm volatile("" : "+v"(lane));
    const int r32 = lane & 31, hi = lane >> 5;
    const long rowbase = (long)b * SEQ; const int q0 = qb * 256;
    const bf16_t* Qw = PROJ + (rowbase + q0 + wid * 32) * PITCH + 2048 + h * 64;
    const bf16_t* Kh = PROJ + rowbase * PITCH + 2560 + h * 64, *Vh = PROJ + rowbase * PITCH + 3072 + h * 64;
    const unsigned lds0 = (unsigned)(uintptr_t)shm;
    const lds_ptr shmw = (lds_ptr)shm;
    __attribute__((address_space(3))) float* wsf = (__attribute__((address_space(3))) float*)(shmw + LDS_WS) + wid * 64;
    const bf16_t* ksrc = Kh + (long)lane * PITCH + wid * 8;
    const bf16_t* vsrc = Vh + (long)(16 * (wid & 3) + (lane >> 2)) * PITCH + (wid >> 2) * 32 + (lane & 3) * 8;
    const unsigned kdst = lds0 + LDS_K + wid * 1024, vdst = lds0 + LDS_V + wid * 1024;
#define TILE(s) (((s) < 4) ? (4 * qb + (s)) : (4 * (qb - 1 - (((s) - 4) >> 2)) + ((s) & 3)))
#define DMA_K(t, slot) glds16(ksrc + (long)TILE(t) * KVBLK * PITCH, (unsigned)__builtin_amdgcn_readfirstlane(kdst + (slot)))
#define DMA_V(t, slot) glds16(vsrc + (long)TILE(t) * KVBLK * PITCH, (unsigned)__builtin_amdgcn_readfirstlane(vdst + (slot)))
    const lds_cptr shm3 = (lds_cptr)shm; const lds_cptr kp0 = shm3 + LDS_K + hi * 1024 + r32 * 16; const lds_cptr vp0 = shm3 + LDS_V + ((lane >> 4) & 1) * 32 + (lane & 3) * 8 + (4 * hi + ((lane & 15) >> 2)) * 64;
    const int NT = 4 * (qb + 1);
    DMA_K(0, 0); DMA_V(0, 0); DMA_K(1, SLOTB);
    bf16x8 qr[4];
#pragma unroll
    for (int d0 = 0; d0 < 4; ++d0) qr[d0] = *reinterpret_cast<const bf16x8*>(&Qw[(long)r32 * PITCH + d0 * 16 + hi * 8]);
    DMA_K(2, 2 * SLOTB);
    unsigned selmask = 0u;
    if (qb > 0) {
        f32x16 gacc = f32x16{};
#pragma unroll
        for (int d0 = 0; d0 < 4; ++d0) {
            u32x4 fh = (u32x4){0u, 0u, 0u, 0u}, fl = (u32x4){0u, 0u, 0u, 0u};
            if (r32 < qb) {
                const float* kp = KSUM + (size_t)((b * 16 + r32) * 2) * 512 + h * 64 + d0 * 16 + hi * 8;
                const f32x4a a0 = *(const f32x4a*)(kp), a1 = *(const f32x4a*)(kp + 4), b0 = *(const f32x4a*)(kp + 512), b1 = *(const f32x4a*)(kp + 516);
                const f32x4a s0 = a0 + b0, s1 = a1 + b1;
#pragma unroll
                for (int j = 0; j < 2; ++j) {
                    const unsigned w0 = cvtpk_s(s0[2 * j], s0[2 * j + 1]), w1 = cvtpk_s(s1[2 * j], s1[2 * j + 1]);
                    fh[j] = w0; fh[2 + j] = w1;
                    fl[j] = cvtpk_s(s0[2 * j] - __uint_as_float(w0 << 16), s0[2 * j + 1] - __uint_as_float(w0 & 0xffff0000u));
                    fl[2 + j] = cvtpk_s(s1[2 * j] - __uint_as_float(w1 << 16), s1[2 * j + 1] - __uint_as_float(w1 & 0xffff0000u)); }
            }
            gacc = MFMA32(__builtin_bit_cast(bf16x8, fh), qr[d0], gacc); gacc = MFMA32(__builtin_bit_cast(bf16x8, fl), qr[d0], gacc);
        }
        __attribute__((address_space(3))) float* gl = (__attribute__((address_space(3))) float*)(shmw + LDS_OST + wid * OST_W);
#pragma unroll
        for (int r = 0; r < 8; ++r) gl[r32 * 17 + crow(r, hi)] = gacc[r];
        asm volatile("s_waitcnt lgkmcnt(0)" ::: "memory");
        float g0 = -INFINITY, g1 = -INFINITY, g2 = -INFINITY; int i0 = -1, i1 = -1, i2 = -1;
#pragma unroll
        for (int j = 0; j < 15; ++j) {
            if (j < qb) { const float g = gl[r32 * 17 + j];
                if (g > g0) { g2 = g1; i2 = i1; g1 = g0; i1 = i0; g0 = g; i0 = j; }
                else if (g > g1) { g2 = g1; i2 = i1; g1 = g; i1 = j; }
                else if (g > g2) { g2 = g; i2 = j; } } }
        if (i0 >= 0) selmask |= 1u << i0; if (i1 >= 0) selmask |= 1u << i1; if (i2 >= 0) selmask |= 1u << i2;
        asm volatile("s_waitcnt lgkmcnt(0)" ::: "memory");
    }
    const unsigned khm = hi ? 0u : 0xffffffffu;
    const float slope2 = __builtin_amdgcn_exp2f(-(float)(h + 1)) * LOG2E;
    const float al0 = slope2 * (float)(r32 - 255);
    u32x4 qx = (u32x4){0x3F803F80u & khm, 0u, 0u, 0u};
#define SET_QX_SEL(bits) do { qx[1] = ((qx[1] & 0xffff0000u) | (unsigned)(bits)) & khm; } while (0)
#define SET_QX_NM(nmv) do { const unsigned h_ = cvtpk_s((nmv), 0.f) & 0xffffu; const float hf_ = __uint_as_float(h_ << 16); const unsigned l_ = cvtpk_s((nmv) - hf_, 0.f) & 0xffffu; \
        qx[1] = ((qx[1] & 0xffffu) | (h_ << 16)) & khm; qx[2] = l_ & khm; mref = -(hf_ + __uint_as_float(l_ << 16)); } while (0)
#define KXF(kx0, kx1, s) do { const float a0_ = slope2 * (float)(64 * (TILE(s) - 4 * qb)) + al0, a1_ = a0_ + 32.f * slope2; \
        const unsigned h0_ = cvtpk_s(a0_, 0.f) & 0xffffu, h1_ = cvtpk_s(a1_, 0.f) & 0xffffu; \
        const unsigned w0_ = h0_ | (cvtpk_s(0.f, a0_ - __uint_as_float(h0_ << 16)) & 0xffff0000u), w1_ = h1_ | (cvtpk_s(0.f, a1_ - __uint_as_float(h1_ << 16)) & 0xffff0000u); \
        kx0 = __builtin_bit_cast(bf16x8, (u32x4){w0_, 0x3F803F80u, 0x00003F80u, 0u}); kx1 = __builtin_bit_cast(bf16x8, (u32x4){w1_, 0x3F803F80u, 0x00003F80u, 0u}); } while (0)
#define QXF __builtin_bit_cast(bf16x8, qx)
#define SELUPD(t) do { if ((t) >= 4 && ((t) & 3) == 0) { const int j_ = qb - 1 - (((t) - 4) >> 2); SET_QX_SEL(((selmask >> j_) & 1u) ? 0u : 0xC700u); } } while (0)
    float mref = 0.f, l_reg = 0.f; f32x16 o[2]; o[0] = f32x16{}; o[1] = f32x16{};
    const f32x16 zero16 = f32x16{};
    const int qrel = wid * 32 + r32;
#define CMASK(P0, P1, t) do { if ((t) < 4) { int qr_ = qrel; asm volatile("" : "+v"(qr_)); cmask(P0, P1, (t), qr_, hi); } } while (0)
    bool resc = false;
#define RESC() do { if (resc) { asm volatile("s_waitcnt lgkmcnt(0)" ::: "memory"); \
        _Pragma("unroll") for (int d_ = 0; d_ < 2; ++d_) _Pragma("unroll") for (int r = 0; r < 16; ++r) o[d_][r] *= wsf[crow(r, hi)]; } } while (0)
    f32x16 pA0, pA1, pB0, pB1;
    int sl_prev = 0, sl_cur = 0, sl_next = SLOTB;
#define ROT() do { sl_prev = sl_cur; sl_cur = sl_next; sl_next = (sl_next == (NSLOT - 1) * SLOTB) ? 0 : sl_next + SLOTB; } while (0)
    WAIT_BAR(3);
    bf16x8 kf[8];
    { bf16x8 kx0, kx1; KXF(kx0, kx1, 0); kload8(kf, kp0);
      pA0 = MFMA32(kx0, QXF, zero16); pA1 = MFMA32(kx1, QXF, zero16);
      pA0 = MFMA32(kf[0], qr[0], pA0); pA1 = MFMA32(kf[1], qr[0], pA1); pA0 = MFMA32(kf[2], qr[1], pA0); pA1 = MFMA32(kf[3], qr[1], pA1);
      pA0 = MFMA32(kf[4], qr[2], pA0); pA1 = MFMA32(kf[5], qr[2], pA1); pA0 = MFMA32(kf[6], qr[3], pA0); pA1 = MFMA32(kf[7], qr[3], pA1);
      { int qr_ = qrel; asm volatile("" : "+v"(qr_)); cmask(pA0, pA1, 0, qr_, hi); }
      const float rm = rowmax(pA0, pA1);
      SET_QX_NM(-rm);
#pragma unroll
      for (int r = 0; r < 16; ++r) { pA0[r] = __builtin_amdgcn_exp2f(pA0[r] - mref); pA1[r] = __builtin_amdgcn_exp2f(pA1[r] - mref); } }
    WAIT_BAR(0);
    if (3 < NT) DMA_K(3, 0);
    DMA_V(1, SLOTB);
    ROT();
    kload8(kf, kp0 + sl_cur);
    WAIT_BAR(2);
    s16x4 vlo[8], vhi[8]; u32x4 pw0, pw1, pw2, pw3;
#define PKW(P, B) cvtpk_s(P[B], P[B + 1])
#define PAF(k) __builtin_bit_cast(bf16x8, pw##k)
#define VFR(i) (bf16x8){vlo[i][0], vlo[i][1], vlo[i][2], vlo[i][3], vhi[i][0], vhi[i][1], vhi[i][2], vhi[i][3]}
#define PIN(x) asm volatile("" : "+v"(x))
#define MX3(a, b, c) __builtin_fmaxf(__builtin_fmaxf((a), (b)), (c))
#define GAPA(MF, A0, A1, A2, A3, W0, W1, PW) do { MF; sacc += A0; sacc += A1; sacc += A2; sacc += A3; PIN(sacc); W0; W1; PIN(PW); SBAR(); } while (0)
#define EX(v) __builtin_amdgcn_exp2f(v)
#define GAPB(MF, X, B) do { MF; X[B] = EX(X[B]); X[B + 1] = EX(X[B + 1]); X[B + 2] = EX(X[B + 2]); X[B + 3] = EX(X[B + 3]); PIN(X); SBAR(); } while (0)
#define VRD(i) do { vlo[i] = vtr(vp_ + (((i) >> 2) * 4096 + ((i) & 3) * 1024)); vhi[i] = vtr(vp_ + (((i) >> 2) * 4096 + ((i) & 3) * 1024 + 512)); } while (0)
#define KRD(G, j) do { if (G) { kload2(kf, kp0 + sl_next, j); SBAR(); } } while (0)
#define STEP(C0, C1, P0, P1, t, GK, GV, GL) do { SBAR(); \
    const lds_cptr vp_ = vp0 + sl_prev; \
    SELUPD(t); bf16x8 kx0_, kx1_; KXF(kx0_, kx1_, t); PIN(kx0_); PIN(kx1_); SBAR(); \
    VRD(0); SBAR(); float sacc = (P0[0] + P0[1]); \
    C0 = MFMA32(kx0_, QXF, zero16); C1 = MFMA32(kx1_, QXF, zero16); SBAR(); \
    GAPA(C0 = MFMA32(kf[0], qr[0], C0), P0[2], P0[3], P0[4], P0[5],     pw0[0] = PKW(P0, 0), pw0[1] = PKW(P0, 2), pw0); \
    VRD(4); SBAR(); GAPA(C1 = MFMA32(kf[1], qr[0], C1), P0[6], P0[7], P0[8], P0[9],     pw0[2] = PKW(P0, 4), pw0[3] = PKW(P0, 6), pw0); \
    VRD(1); SBAR(); GAPA(C0 = MFMA32(kf[2], qr[1], C0),   P0[10], P0[11], P0[12], P0[13], pw1[0] = PKW(P0, 8), pw1[1] = PKW(P0, 10), pw1); \
    VRD(5); SBAR(); GAPA(C1 = MFMA32(kf[3], qr[1], C1),   P0[14], P0[15], P1[0], P1[1],   pw1[2] = PKW(P0, 12), pw1[3] = PKW(P0, 14), pw1); \
    VRD(2); SBAR(); GAPA(C0 = MFMA32(kf[4], qr[2], C0),   P1[2], P1[3], P1[4], P1[5],     pw2[0] = PKW(P1, 0), pw2[1] = PKW(P1, 2), pw2); \
    VRD(6); SBAR(); GAPA(C1 = MFMA32(kf[5], qr[2], C1),   P1[6], P1[7], P1[8], P1[9],     pw2[2] = PKW(P1, 4), pw2[3] = PKW(P1, 6), pw2); \
    VRD(3); SBAR(); GAPA(C0 = MFMA32(kf[6], qr[3], C0),   P1[10], P1[11], P1[12], P1[13], pw3[0] = PKW(P1, 8), pw3[1] = PKW(P1, 10), pw3); \
    VRD(7); SBAR(); GAPA(C1 = MFMA32(kf[7], qr[3], C1),   P1[14], P1[15], 0.f, 0.f,       pw3[2] = PKW(P1, 12), pw3[3] = PKW(P1, 14), pw3); \
    l_reg += sacc; \
    if (GK) { DMA_K((t) + 3, sl_cur); } if (GV) { DMA_V((t) + 1, sl_next); } \
    CMASK(C0, C1, t); \
    { float a = MX3(C0[0], C0[1], C1[0]), b_ = MX3(C0[2], C0[3], C1[1]); a = MX3(a, C1[2], C1[3]); \
      _Pragma("unroll") for (int r = 4; r < 16; r += 4) { a = MX3(a, C0[r], C0[r + 1]); b_ = MX3(b_, C0[r + 2], C0[r + 3]); a = MX3(a, C1[r], C1[r + 1]); b_ = MX3(b_, C1[r + 2], C1[r + 3]); } \
      float rm = __builtin_fmaxf(a, b_); { auto rr = __builtin_amdgcn_permlane32_swap(__float_as_uint(rm), __float_as_uint(rm), false, false); rm = __builtin_fmaxf(__uint_as_float(rr[0]), __uint_as_float(rr[1])); } \
      resc = false; \
      if (__builtin_expect(__any(rm > (float)THRL), 0)) { const float mold = mref; const float nmv = -(mref + __builtin_fmaxf(rm, 0.f)); SET_QX_NM(nmv); const float dl = mref - mold; \
        _Pragma("unroll") for (int r = 0; r < 16; ++r) { C0[r] -= dl; C1[r] -= dl; } \
        const float f = __builtin_amdgcn_exp2f(-dl); l_reg *= f; if (hi == 0) wsf[r32] = f; resc = true; } } \
    SBAR(); \
    GAPB(o[0] = MFMA32(PAF(0), VFR(0), o[0]), C0, 0); \
    GAPB(o[1] = MFMA32(PAF(0), VFR(4), o[1]), C0, 4); \
    KRD(GL, 0); GAPB(o[0] = MFMA32(PAF(1), VFR(1), o[0]), C0, 8); \
    KRD(GL, 1); GAPB(o[1] = MFMA32(PAF(1), VFR(5), o[1]), C0, 12); \
    KRD(GL, 2); GAPB(o[0] = MFMA32(PAF(2), VFR(2), o[0]), C1, 0); \
    KRD(GL, 3); GAPB(o[1] = MFMA32(PAF(2), VFR(6), o[1]), C1, 4); \
    GAPB(o[0] = MFMA32(PAF(3), VFR(3), o[0]), C1, 8); \
    GAPB(o[1] = MFMA32(PAF(3), VFR(7), o[1]), C1, 12); \
    } while (0)
#define ENDW(tt) do { if ((tt) + 3 < NT) { WAIT_BAR(2); } else if ((tt) + 2 < NT) { WAIT_BAR(1); } else { WAIT_BAR(0); } } while (0)
    int t = 1;
    STEP(pB0, pB1, pA0, pA1, t, (t + 3 < NT), true, true);       ENDW(t);     RESC(); ROT();
    STEP(pA0, pA1, pB0, pB1, t + 1, (t + 4 < NT), true, true);   ENDW(t + 1); RESC(); ROT();
    t = 3;
    if (NT > 4) {
        STEP(pB0, pB1, pA0, pA1, t, true, true, true);               ENDW(t);     RESC(); ROT();
        STEP(pA0, pA1, pB0, pB1, t + 1, (t + 4 < NT), true, true);   ENDW(t + 1); RESC(); ROT();
        t = 5;
        for (; t + 5 < NT; t += 2) {
            STEP(pB0, pB1, pA0, pA1, t, true, true, true);       WAIT_BAR(2); RESC(); ROT();
            STEP(pA0, pA1, pB0, pB1, t + 1, true, true, true);   WAIT_BAR(2); RESC(); ROT();
        }
        for (; t + 1 < NT; t += 2) {
            STEP(pB0, pB1, pA0, pA1, t, (t + 3 < NT), (t + 1 < NT), (t + 1 < NT));       ENDW(t);     RESC(); ROT();
            STEP(pA0, pA1, pB0, pB1, t + 1, (t + 4 < NT), (t + 2 < NT), (t + 2 < NT));   ENDW(t + 1); RESC(); ROT();
        }
    }
    STEP(pB0, pB1, pA0, pA1, NT - 1, false, false, false); RESC();
    { float sacc = pB0[0] + pB0[1];
#pragma unroll
      for (int r = 2; r < 16; ++r) sacc += pB0[r];
#pragma unroll
      for (int r = 0; r < 16; ++r) sacc += pB1[r];
      l_reg += sacc;
      pw0 = (u32x4){PKW(pB0, 0), PKW(pB0, 2), PKW(pB0, 4), PKW(pB0, 6)}; pw1 = (u32x4){PKW(pB0, 8), PKW(pB0, 10), PKW(pB0, 12), PKW(pB0, 14)};
      pw2 = (u32x4){PKW(pB1, 0), PKW(pB1, 2), PKW(pB1, 4), PKW(pB1, 6)}; pw3 = (u32x4){PKW(pB1, 8), PKW(pB1, 10), PKW(pB1, 12), PKW(pB1, 14)};
      SBAR(); pv(o, vp0 + sl_cur, PAF(0), PAF(1), PAF(2), PAF(3)); }
    { auto rr = __builtin_amdgcn_permlane32_swap(__float_as_uint(l_reg), __float_as_uint(l_reg), false, false); l_reg = __uint_as_float(rr[0]) + __uint_as_float(rr[1]); }
    if (hi == 0) wsf[32 + r32] = l_reg; asm volatile("s_waitcnt lgkmcnt(0)" ::: "memory");
#pragma unroll
    for (int r = 0; r < 16; ++r) { const float rli = __builtin_amdgcn_rcpf(wsf[32 + crow(r, hi)]); o[0][r] *= rli; o[1][r] *= rli; }
    asm volatile("s_waitcnt vmcnt(0)" ::: "memory");
    attn_epilogue(o, shm, wid, lane, PROJ + (rowbase + q0 + wid * 32) * PITCH + 3584 + h * 64, g_mb + h * 64, Y + (rowbase + q0 + wid * 32) * DM + 512 + h * 64, SSQ + (rowbase + q0 + wid * 32) * 16 + 8 + h);
    asm volatile("s_waitcnt vmcnt(0) lgkmcnt(0)\n\ts_barrier" ::: "memory");
#undef TILE
#undef DMA_K
#undef DMA_V
#undef SET_QX_SEL
#undef SET_QX_NM
#undef KXF
#undef QXF
#undef SELUPD
#undef CMASK
#undef RESC
#undef ROT
#undef PKW
#undef PAF
#undef VFR
#undef PIN
#undef MX3
#undef GAPA
#undef GAPB
#undef EX
#undef VRD
#undef KRD
#undef STEP
#undef ENDW
}
#undef SBAR
#undef WAIT_BAR
#undef MFMA32
}

constexpr int NWAVES = 8;
constexpr int CW_TMO = 0, CW_CODE = 1;
constexpr int CW_BAR = 4096;
constexpr int RING_OFF = 0, RING_BYTES = 131072;
constexpr int LDSCTL_OFF = RING_BYTES, MISC_OFF = LDSCTL_OFF + 320;
constexpr int TAB_OFF = LDSCTL_OFF + 1024;
constexpr int LDS_BYTES = 147456;
static_assert(TAB_OFF + 4096 <= LDS_BYTES, "LDS map");

#define GAS __attribute__((address_space(1)))
#define LAS __attribute__((address_space(3)))
typedef unsigned short bf16;
typedef unsigned v4u __attribute__((ext_vector_type(4)));
typedef float f32x4 __attribute__((ext_vector_type(4)));
typedef short bf16x8 __attribute__((ext_vector_type(8)));
typedef GAS unsigned gu32;
typedef GAS unsigned long long gu64;
#define RLX_AGENT __ATOMIC_RELAXED, __HIP_MEMORY_SCOPE_AGENT
#define LDS_WAIT() asm volatile("s_waitcnt lgkmcnt(0)" ::: "memory")
#define VM_WAIT() asm volatile("s_waitcnt vmcnt(0)" ::: "memory")
__device__ __forceinline__ unsigned long long rt() { return __builtin_amdgcn_s_memrealtime(); }
__device__ __forceinline__ unsigned f2bf_u(float f) { unsigned u = __builtin_bit_cast(unsigned, f); return (u + 0x7fffu + ((u >> 16) & 1u)) >> 16; }
__device__ __forceinline__ unsigned pk2(float lo, float hi) { return f2bf_u(lo) | (f2bf_u(hi) << 16); }

#define XB_TMO      128
#define XB_XCNT(j)  (256  + 64 * (j))
#define XB_XSUB(j)  (1280 + 64 * (j))
#define XB_XGEN(j)  (2304 + 64 * (j))
#define XB_TOP      3328
#define XB_TOPGEN   3392
#define XCD_BAR_WORDS 3456
#define XB_SPIN_CAP (1u << 18)

__device__ __forceinline__ unsigned xb_ld(unsigned* p)              { return __hip_atomic_load(p, __ATOMIC_RELAXED, __HIP_MEMORY_SCOPE_AGENT); }
__device__ __forceinline__ unsigned xb_add(unsigned* p, unsigned v) { return __hip_atomic_fetch_add(p, v, __ATOMIC_RELAXED, __HIP_MEMORY_SCOPE_AGENT); }
__device__ __forceinline__ unsigned xb_xcc_id() { return (unsigned)__builtin_amdgcn_s_getreg((3 << 11) | 20) & 0xFu; }
#define XB_SPIN(cond, bar) do { unsigned _sp = 0; while (cond) { __builtin_amdgcn_s_sleep(1); \
    if ((++_sp & 255u) == 0u) { if (xb_ld(&(bar)[XB_TMO])) break; if (_sp > XB_SPIN_CAP) { atomicAdd(&(bar)[XB_TMO], 1u); break; } } } } while (0)

struct XcdBarrier {
    unsigned* bar; unsigned x;
    volatile LAS unsigned* st;
};

__device__ __forceinline__ XcdBarrier xcd_barrier_post(unsigned* bar, volatile LAS unsigned* st) {
    XcdBarrier b; b.bar = bar; b.x = xb_xcc_id(); b.st = st;
    if (threadIdx.x == 0) (void)xb_add(&bar[XB_XCNT(b.x)], 1u);
    return b;
}
__device__ __forceinline__ void xcd_barrier_complete(unsigned* bar, unsigned x, unsigned& nloc, unsigned& nx) {
    const unsigned G = gridDim.x * gridDim.y * gridDim.z;
    unsigned sum, cnt, mine, sp = 0u;
    for (;;) {
        sum = 0u; cnt = 0u; mine = 0u;
#pragma unroll
        for (unsigned j = 0; j < 16; ++j) { const unsigned c = xb_ld(&bar[XB_XCNT(j)]); sum += c; cnt += (c > 0u) ? 1u : 0u; mine = (j == x) ? c : mine; }
        if (sum == G) break;
        __builtin_amdgcn_s_sleep(1);
        if ((++sp & 255u) == 0u) { if (xb_ld(&bar[XB_TMO])) break; if (sp > XB_SPIN_CAP) { atomicAdd(&bar[XB_TMO], 1u); break; } }
    }
    nloc = mine > 0u ? mine : 1u; nx = cnt > 0u ? cnt : 1u;
}

__device__ __forceinline__ void xcd_barrier(const XcdBarrier& b) {
    asm volatile("s_waitcnt vmcnt(0)" ::: "memory");
    __syncthreads();
    if (threadIdx.x == 0) {
        unsigned* bar = b.bar;
        __builtin_amdgcn_s_waitcnt(0);
        unsigned nloc = b.st[0], nx = b.st[1];
        if (nloc == 0u) { xcd_barrier_complete(bar, b.x, nloc, nx); b.st[0] = nloc; b.st[1] = nx; }
        const unsigned old = xb_add(&bar[XB_XSUB(b.x)], 1u);
        const unsigned gen = old / nloc;
        if (old + 1u == (gen + 1u) * nloc) {
            __builtin_amdgcn_fence(__ATOMIC_RELEASE, "agent");
            asm volatile("s_waitcnt vmcnt(0)" ::: "memory");
            const unsigned og = xb_add(&bar[XB_TOP], 1u);
            const unsigned tg = og / nx;
            if (og + 1u == (tg + 1u) * nx) xb_add(&bar[XB_TOPGEN], 1u);
            else XB_SPIN(xb_ld(&bar[XB_TOPGEN]) == tg, bar);
            __builtin_amdgcn_fence(__ATOMIC_ACQUIRE, "agent");
            xb_add(&bar[XB_XGEN(b.x)], 1u);
            asm volatile("s_waitcnt vmcnt(0)" ::: "memory");
        } else {
            XB_SPIN(xb_ld(&bar[XB_XGEN(b.x)]) == gen, bar);
            __builtin_amdgcn_fence(__ATOMIC_ACQUIRE, "agent");
            asm volatile("s_waitcnt vmcnt(0)" ::: "memory");
        }
    }
    __syncthreads();
}

struct Frame {
    LAS unsigned char* lds;
    volatile LAS unsigned* MISC;
    gu32* ctl;
    int wave;
    int vcu, G;
};
#define LANE_ID() ((int)__builtin_amdgcn_mbcnt_hi(~0u, __builtin_amdgcn_mbcnt_lo(~0u, 0u)))
__device__ __forceinline__ float wave_sum(float v) {
#pragma unroll
    for (int o = 1; o < 64; o <<= 1) v += __shfl_xor(v, o);
    return v;
}
__device__ __forceinline__ void p0_transpose_item(const float* W, int K, int N, bf16* WT, const float* rs, LAS float* scr, int item, int lane) {
    const int nblk = N / 32, kb = item / nblk, nb = item % nblk, k0 = 64 * kb, n0 = 32 * nb;
#pragma unroll 8
    for (int i = 0; i < 32; ++i) { const int kk = 2 * i + (lane >> 5); float v = W[(size_t)(k0 + kk) * N + n0 + (lane & 31)]; if (rs) v *= rs[k0 + kk]; scr[kk * 33 + (lane & 31)] = v; }
    LDS_WAIT(); asm volatile("" ::: "memory");
    const int c = lane & 7;
#pragma unroll
    for (int j = 0; j < 4; ++j) { const int n = (lane >> 3) + 8 * j; const LAS float* s = scr + (8 * c) * 33 + n;
        v4u o; o.x = pk2(s[0 * 33], s[1 * 33]); o.y = pk2(s[2 * 33], s[3 * 33]); o.z = pk2(s[4 * 33], s[5 * 33]); o.w = pk2(s[6 * 33], s[7 * 33]);
        *(GAS v4u*)(WT + (size_t)(n0 + n) * K + k0 + 8 * c) = o; }
    LDS_WAIT(); asm volatile("" ::: "memory");
}
__device__ __forceinline__ void rms_row_to_bf16(const float* xrow, const float* g, bf16* orow, int lane) {
    const GAS f32x4* xr = (const GAS f32x4*)xrow + lane; const GAS f32x4* gr = (const GAS f32x4*)g + lane;
    f32x4 v[4]; float s = 0.f;
#pragma unroll
    for (int j = 0; j < 4; ++j) { v[j] = xr[64 * j]; s += (v[j].x * v[j].x + v[j].y * v[j].y) + (v[j].z * v[j].z + v[j].w * v[j].w); }
    const float rstd = 1.f / sqrtf(wave_sum(s) * (1.f / DM) + RMS_EPS);
    GAS unsigned long long* o8 = (GAS unsigned long long*)orow + lane;
#pragma unroll
    for (int j = 0; j < 4; ++j) { const f32x4 gg = gr[64 * j]; o8[64 * j] = (unsigned long long)pk2(v[j].x * rstd * gg.x, v[j].y * rstd * gg.y) | ((unsigned long long)pk2(v[j].z * rstd * gg.z, v[j].w * rstd * gg.w) << 32); }
}
__device__ __forceinline__ void final_norm_row(float* xrow, const float* g, int lane) {
    GAS f32x4* xr = (GAS f32x4*)xrow + lane; const GAS f32x4* gr = (const GAS f32x4*)g + lane;
    f32x4 v[4]; float s = 0.f;
#pragma unroll
    for (int j = 0; j < 4; ++j) { v[j] = xr[64 * j]; s += (v[j].x * v[j].x + v[j].y * v[j].y) + (v[j].z * v[j].z + v[j].w * v[j].w); }
    const float rstd = 1.f / sqrtf(wave_sum(s) * (1.f / DM) + RMS_EPS);
#pragma unroll
    for (int j = 0; j < 4; ++j) { const f32x4 gg = gr[64 * j]; xr[64 * j] = v[j] * rstd * gg; }
}

struct Args { const float* in[11]; float* out; unsigned char* ws; int ph_lo, ph_hi, li, pad; };
__global__ void __launch_bounds__(NWAVES * 64, 2) mk_fwd(Args args) {
    extern __shared__ __attribute__((aligned(16))) unsigned char lds[];
    Frame F;
    F.lds = (LAS unsigned char*)lds;
    F.MISC = (volatile LAS unsigned*)(F.lds + MISC_OFF);
    F.wave = __builtin_amdgcn_readfirstlane((int)(threadIdx.x >> 6));
    F.G = gridDim.x; { const int bx = blockIdx.x; F.vcu = (F.G % 8 == 0) ? (bx % 8) * (F.G / 8) + bx / 8 : bx; }
    unsigned char* ws = args.ws;
    F.ctl = (gu32*)(ws + WS_CTL);
    const float* x = args.in[0]; const float* p = args.in[1]; const float* w_in = args.in[2]; const float* g_mix = args.in[3];
    const float* g_sb = args.in[4]; const float* g_mb = args.in[5]; const float* w_out = args.in[6]; const float* w_ple = args.in[7]; const float* g_ple = args.in[8]; const float* w_gate = args.in[9]; const float* g_final = args.in[10];
    float* out = args.out;
    bf16* WT_IN = (bf16*)(ws + WS_WT_IN); bf16* WT_OUT = (bf16*)(ws + WS_WT_OUT); bf16* WT_GATE = (bf16*)(ws + WS_WT_GATE); bf16* WT_PLE = (bf16*)(ws + WS_WT_PLE);
    float* KSUM = (float*)(ws + WS_KSUM); float* SSQ = (float*)(ws + WS_SSQ); float* SSQ1 = (float*)(ws + WS_SSQ1);
    bf16* XN = (bf16*)(ws + WS_XN); bf16* Y = (bf16*)(ws + WS_Y); bf16* PB = (bf16*)(ws + WS_PB); bf16* PLE = (bf16*)(ws + WS_PLE);
    bf16* X1 = (bf16*)(ws + WS_X1); bf16* PROJ = (bf16*)(ws + WS_PROJ);
    for (int u = threadIdx.x; u < (LDS_BYTES - LDSCTL_OFF) / 4; u += NWAVES * 64) ((LAS unsigned*)(F.lds + LDSCTL_OFF))[u] = 0u;
    __syncthreads();
    XcdBarrier bar = xcd_barrier_post((unsigned*)(F.ctl + CW_BAR) + args.li * XCD_BAR_WORDS, F.MISC + 8);
    const int lo = args.ph_lo, hi = args.ph_hi;
#define IN(k) (lo <= (k) && (k) < hi)
#define BOTH(k) (IN(k) && IN((k) + 1))
    const int gw = F.vcu * NWAVES + F.wave, NGW = F.G * NWAVES;
    LAS pg8::f32x2* tab = (LAS pg8::f32x2*)(F.lds + TAB_OFF);

    if (((MK_BUILD >> 0) & 1) && IN(0)) {
        LAS float* scr = (LAS float*)(F.lds + RING_OFF + F.wave * 16384);
        constexpr int I_IN = (DM / 64) * (NPROJ / 32), I_SQ = (DM / 64) * (DM / 32), I_PLE = (DPLE / 64) * (DM / 32);
        constexpr int NITEMS = I_IN + 2 * I_SQ + I_PLE;
        for (int it = gw; it < NITEMS; it += NGW) {
            int r = it;
            if (r < I_IN) { p0_transpose_item(w_in, DM, NPROJ, WT_IN, nullptr, scr, r, LANE_ID()); continue; } r -= I_IN;
            if (r < I_SQ) { p0_transpose_item(w_out, DM, DM, WT_OUT, nullptr, scr, r, LANE_ID()); continue; } r -= I_SQ;
            if (r < I_SQ) { p0_transpose_item(w_gate, DM, DM, WT_GATE, g_ple, scr, r, LANE_ID()); continue; } r -= I_SQ;
            p0_transpose_item(w_ple, DPLE, DM, WT_PLE, nullptr, scr, r, LANE_ID());
        }
        for (int m = gw; m < MTOK; m += NGW) {
            rms_row_to_bf16(x + (size_t)m * DM, g_mix, XN + (size_t)m * DM, LANE_ID());
            const f32x4 pv = ((const GAS f32x4*)(p + (size_t)m * DPLE))[LANE_ID()];
            ((GAS unsigned long long*)(PB + (size_t)m * DPLE))[LANE_ID()] = (unsigned long long)pk2(pv.x, pv.y) | ((unsigned long long)pk2(pv.z, pv.w) << 32);
        }
        if (BOTH(0)) xcd_barrier(bar);
    }
    if (((MK_BUILD >> 1) & 1) && IN(1)) {
        { pg8::Gemm g{XN, WT_IN, MTOK, NPROJ, DM}; pg8::StaticOrder S; S.init(MTOK, NPROJ, F.G, (int)blockIdx.x);
          pg8::EpiProj E{PROJ, KSUM};
          pg8::gemm_phase<pg8::EpiProj, pg8::StaticOrder, true, true, false>(F.lds + RING_OFF, g, S, E, F.wave); }
        { pg8::Gemm g{PB, WT_PLE, MTOK, DM, DPLE}; pg8::StaticOrder S; S.init(MTOK, DM, F.G, (int)blockIdx.x);
          pg8::EpiStore E{PLE, DM};
          pg8::gemm_phase<pg8::EpiStore, pg8::StaticOrder, true, true, false>(F.lds + RING_OFF, g, S, E, F.wave); }
        if (BOTH(1)) xcd_barrier(bar);
    }
    if (((MK_BUILD >> 2) & 1) && IN(2)) {
        char* shm = (char*)lds + RING_OFF;
        for (int vv = F.vcu; vv < 256; vv += F.G) {
            const int bh = vv >> 2, s4 = vv & 3, b = bh >> 3, h = bh & 7;
            if (P2_PARTS & 2) for (int k = 0; k < 4; ++k) { const int qb = (k == 0) ? 15 - s4 : (k == 1) ? 11 - s4 : (k == 2) ? s4 + 4 : s4; att::moba_unit<8>(b, h, qb, PROJ, KSUM, g_mb, Y, SSQ, shm, F.wave); }
            if (P2_PARTS & 1) for (int k = 0; k < 4; ++k) att::sb_unit(b, h, s4 + 4 * k, PROJ, g_sb, Y, SSQ, shm, F.wave);
        }
        if (BOTH(2)) xcd_barrier(bar);
    }
    if (((MK_BUILD >> 3) & 1) && IN(3)) {
        pg8::Gemm g{Y, WT_OUT, MTOK, DM, DM}; pg8::StaticOrder S; S.init(MTOK, DM, F.G, (int)blockIdx.x);
        { pg8::Unit uu; const int tid_ = F.wave * 64 + LANE_ID(); const int un = tid_ >> 8, r = tid_ & 255;
          if (S.next(un, uu)) { const GAS f32x4* q = (const GAS f32x4*)(SSQ + (size_t)(uu.pm * 256 + r) * 16);
              const f32x4 a0 = q[0], a1 = q[1], b0 = q[2], b1 = q[3];
              const float a = ((a0.x + a0.y) + (a0.z + a0.w)) + ((a1.x + a1.y) + (a1.z + a1.w)), b = ((b0.x + b0.y) + (b0.z + b0.w)) + ((b1.x + b1.y) + (b1.z + b1.w));
              const float ra = 1.f / sqrtf(a * (1.f / 512.f) + RMS_EPS), rb = 1.f / sqrtf(b * (1.f / 512.f) + RMS_EPS);
              tab[un * 256 + r] = (pg8::f32x2){ra / rb, rb}; } }
        LDS_WAIT(); __syncthreads();
        pg8::EpiOut E{x, X1, SSQ1, (const LAS pg8::f32x2*)tab};
        pg8::gemm_phase<pg8::EpiOut, pg8::StaticOrder, true, true, true>(F.lds + RING_OFF, g, S, E, F.wave);
        if (BOTH(3)) xcd_barrier(bar);
    }
    if (((MK_BUILD >> 4) & 1) && IN(4)) {
        pg8::Gemm g{X1, WT_GATE, MTOK, DM, DM}; pg8::StaticOrder S; S.init(MTOK, DM, F.G, (int)blockIdx.x);
        __syncthreads();
        { pg8::Unit uu; const int tid_ = F.wave * 64 + LANE_ID(); const int un = tid_ >> 8, r = tid_ & 255;
          if (S.next(un, uu)) { const GAS f32x4* q = (const GAS f32x4*)(SSQ1 + (size_t)(uu.pm * 256 + r) * 16);
              const f32x4 a0 = q[0], a1 = q[1], b0 = q[2], b1 = q[3];
              const float a = (((a0.x + a0.y) + (a0.z + a0.w)) + ((a1.x + a1.y) + (a1.z + a1.w))) + (((b0.x + b0.y) + (b0.z + b0.w)) + ((b1.x + b1.y) + (b1.z + b1.w)));
              tab[un * 256 + r] = (pg8::f32x2){1.f / sqrtf(a * (1.f / DM) + RMS_EPS), 0.f}; } }
        LDS_WAIT(); __syncthreads();
        pg8::EpiGate E{X1, PLE, out, (const LAS pg8::f32x2*)tab};
        pg8::gemm_phase<pg8::EpiGate, pg8::StaticOrder, true, true, false>(F.lds + RING_OFF, g, S, E, F.wave);
        if (BOTH(4)) xcd_barrier(bar);
    }
    if (((MK_BUILD >> 5) & 1) && IN(5)) {
        for (int m = gw; m < MTOK; m += NGW) final_norm_row(out + (size_t)m * DM, g_final, LANE_ID());
    }
#undef IN
#undef BOTH
}

#ifndef MK_BUILD
#define MK_BUILD 0x3F
#endif
#ifndef MK_MASK
#define MK_MASK 0x3F
#endif
extern "C" void kernel_launch(void* const* d_in, const int* in_sizes, int n_in, void* d_out, int out_size, void* d_ws, size_t ws_size, hipStream_t stream) {
    static int grid = 0;
    if (grid == 0) {
        if (n_in != 11 || in_sizes[0] != MTOK * DM || out_size != MTOK * DM || ws_size < WS_END) {
            fprintf(stderr, "kernel_launch: unexpected shapes n_in %d in0 %d out %d ws %zu\n", n_in, n_in > 0 ? in_sizes[0] : -1, out_size, ws_size); grid = -1; return; }
        int dev = 0, cus = 0;
        if (hipGetDevice(&dev) != hipSuccess || hipDeviceGetAttribute(&cus, hipDeviceAttributeMultiprocessorCount, dev) != hipSuccess) { grid = -1; return; }
        if (hipFuncSetAttribute((const void*)mk_fwd, hipFuncAttributeMaxDynamicSharedMemorySize, LDS_BYTES) != hipSuccess) { fprintf(stderr, "kernel_launch: hipFuncSetAttribute failed\n"); grid = -1; return; }
        int per_cu = 0;
        if (hipOccupancyMaxActiveBlocksPerMultiprocessor(&per_cu, (const void*)mk_fwd, NWAVES * 64, LDS_BYTES) != hipSuccess || per_cu < 1) { fprintf(stderr, "kernel_launch: occupancy query says %d\n", per_cu); }
        (void)hipGetLastError();
        grid = cus;
    }
    if (grid < 0) return;
    const float* x = (const float*)d_in[0]; const float* p = (const float*)d_in[1]; const float* w_in = (const float*)d_in[2];
    const float* g_mix = (const float*)d_in[3]; const float* g_sb = (const float*)d_in[4]; const float* g_mb = (const float*)d_in[5];
    const float* w_out = (const float*)d_in[6]; const float* w_ple = (const float*)d_in[7]; const float* g_ple = (const float*)d_in[8];
    const float* w_gate = (const float*)d_in[9]; const float* g_final = (const float*)d_in[10];
    unsigned char* ws = (unsigned char*)d_ws; float* out = (float*)d_out;
    bf16_t* WT_IN = (bf16_t*)(ws + WS_WT_IN); bf16_t* WT_OUT = (bf16_t*)(ws + WS_WT_OUT); bf16_t* WT_GATE = (bf16_t*)(ws + WS_WT_GATE); bf16_t* WT_PLE = (bf16_t*)(ws + WS_WT_PLE);
    float* KSUM = (float*)(ws + WS_KSUM); float* SSQ = (float*)(ws + WS_SSQ); float* SSQ1 = (float*)(ws + WS_SSQ1);
    bf16_t* XN = (bf16_t*)(ws + WS_XN); bf16_t* Y = (bf16_t*)(ws + WS_Y); bf16_t* PB = (bf16_t*)(ws + WS_PB); bf16_t* PLE = (bf16_t*)(ws + WS_PLE);
    bf16_t* X1 = (bf16_t*)(ws + WS_X1); bf16_t* PROJ = (bf16_t*)(ws + WS_PROJ);
    (void)hipMemsetAsync(ws + WS_CTL, 0, CTL_ZERO_BYTES, stream);
    Args a{};
    for (int i = 0; i < 11; ++i) a.in[i] = (const float*)d_in[i];
    a.out = out; a.ws = ws;
    int li = 0;
    for (int ph = 0; ph < 6;) {
        if ((MK_MASK >> ph) & 1) {
            int e = ph; while (e < 6 && ((MK_MASK >> e) & 1)) { ++e; if (e == 3 && P2_PARTS != 3) break; }
            a.ph_lo = ph; a.ph_hi = e; a.li = li++;
            hipLaunchKernelGGL(mk_fwd, dim3(grid), dim3(NWAVES * 64), LDS_BYTES, stream, a);
            if (e == 3 && P2_PARTS != 3) {
                if (!(P2_PARTS & 1)) nv_sb<<<dim3(SEQ / 64, NB * NH), 64, 0, stream>>>(PROJ, g_sb, Y, SSQ);
                if (!(P2_PARTS & 2)) nv_moba<<<dim3(SEQ / 64, NB * NH), 64, 0, stream>>>(PROJ, KSUM, g_mb, Y, SSQ);
            }
            ph = e; continue;
        }
        EpiP ep{};
        switch (ph) {
        case 0:
            nv_transpose_w<<<(DM * NPROJ + 255) / 256, 256, 0, stream>>>(w_in, DM, NPROJ, WT_IN, nullptr);
            nv_transpose_w<<<(DM * DM + 255) / 256, 256, 0, stream>>>(w_out, DM, DM, WT_OUT, nullptr);
            nv_transpose_w<<<(DM * DM + 255) / 256, 256, 0, stream>>>(w_gate, DM, DM, WT_GATE, g_ple);
            nv_transpose_w<<<(DPLE * DM + 255) / 256, 256, 0, stream>>>(w_ple, DPLE, DM, WT_PLE, nullptr);
            nv_rmsnorm_bf16<<<MTOK / 4, 256, 0, stream>>>(x, g_mix, XN);
            nv_cvt_bf16<<<(MTOK * DPLE + 255) / 256, 256, 0, stream>>>(p, PB, (size_t)MTOK * DPLE);
            break;
        case 1:
            ep.obf = PROJ; nv_gemm<EPI_PROJ><<<dim3(NPROJ / 128, MTOK / 128), 256, 0, stream>>>(XN, WT_IN, MTOK, NPROJ, DM, ep);
            ep = EpiP{}; ep.obf = PLE; nv_gemm<EPI_PLE><<<dim3(DM / 128, MTOK / 128), 256, 0, stream>>>(PB, WT_PLE, MTOK, DM, DPLE, ep);
            nv_ksum<<<MTOK / 256, 512, 0, stream>>>(PROJ, KSUM);
            break;
        case 2:
            nv_sb<<<dim3(SEQ / 64, NB * NH), 64, 0, stream>>>(PROJ, g_sb, Y, SSQ);
            nv_moba<<<dim3(SEQ / 64, NB * NH), 64, 0, stream>>>(PROJ, KSUM, g_mb, Y, SSQ);
            break;
        case 3:
            ep.obf = X1; ep.x = x; ep.ssq = SSQ; nv_gemm<EPI_OUT><<<dim3(DM / 128, MTOK / 128), 256, 0, stream>>>(Y, WT_OUT, MTOK, DM, DM, ep);
            nv_ssq1<<<MTOK / 4, 256, 0, stream>>>(X1, SSQ1);
            break;
        case 4:
            ep.of32 = out; ep.ssq1 = SSQ1; ep.x1 = X1; ep.ple = PLE; nv_gemm<EPI_GATE><<<dim3(DM / 128, MTOK / 128), 256, 0, stream>>>(X1, WT_GATE, MTOK, DM, DM, ep);
            break;
        default:
            nv_final_norm<<<MTOK / 4, 256, 0, stream>>>(out, g_final);
            break;
        }
        ++ph;
    }
}
```
